# Optimizing an MI355X kernel written in HIP

```python
import math
import jax, jax.numpy as jnp
from jax import lax
import numpy as np

D_MODEL = 1024
BATCH = 32
SEQ = 2048
DEPTH = 2

GRID_W = 64
CTX_LEN = 256
HEAD_DIM = 64
A_HEADS = 6
A_KV_HEADS = 2
C_HEADS = 6
C_KV_HEADS = 2
HY_WIDTH = 256
HY_ORDER = 2
HY_BANDS = 16
HY_EMB = 1 + 2 * HY_BANDS
HY_HIDDEN = 64
HY_SHORT = 3
HY_FAST_DECAY = 0.3
HY_SLOW_DECAY = 1.5
HY_TARGET = 1e-2
BLOCK = 128
WINDOW = 128
ROPE_THETA = 10000.0
NORM_EPS = 1e-6
NEG_INF = -1e30
MIX_WIDTH = (A_HEADS + C_HEADS) * HEAD_DIM + HY_WIDTH
IN_SIZES = (A_HEADS * HEAD_DIM, A_KV_HEADS * HEAD_DIM, A_KV_HEADS * HEAD_DIM, A_HEADS * HEAD_DIM,
            HY_WIDTH, HY_WIDTH, HY_WIDTH, HY_WIDTH,
            C_HEADS * HEAD_DIM, C_KV_HEADS * HEAD_DIM, C_KV_HEADS * HEAD_DIM, C_HEADS * HEAD_DIM)
IN_WIDTH = sum(IN_SIZES)

kernel_name = "hymba_style_gqa_hyena_swa_diffusion_block"


def _in_bounds():
    return [int(v) for v in np.cumsum((0,) + IN_SIZES)]


def _split_in(p):
    return jnp.split(p, _in_bounds()[1:-1], axis=-1)


def _rmsnorm(x, g):
    xf = x.astype(jnp.float32)
    y = xf * lax.rsqrt(jnp.mean(xf * xf, axis=-1, keepdims=True) + NORM_EPS)
    return (y * g.astype(jnp.float32)).astype(x.dtype)


def _axial_rope_tables(L, dtype):
    rows = L // GRID_W
    row = jnp.repeat(jnp.arange(rows), GRID_W, total_repeat_length=rows * GRID_W)
    col = jnp.tile(jnp.arange(GRID_W), rows)
    n_freq = HEAD_DIM // 4
    inv_freq = ROPE_THETA ** (-jnp.arange(n_freq, dtype=jnp.float32) / n_freq)
    ang = jnp.stack([row.astype(jnp.float32)[:, None] * inv_freq,
                     col.astype(jnp.float32)[:, None] * inv_freq], axis=1)
    return jnp.cos(ang).astype(dtype), jnp.sin(ang).astype(dtype)


def _apply_rope(x, cos, sin):
    B, L, H, _ = x.shape
    xr = x.reshape(B, L, H, 2, 2, HEAD_DIM // 4)
    xa, xb = xr[..., 0, :], xr[..., 1, :]
    c, s = cos[None, :, None], sin[None, :, None]
    out = jnp.stack([xa * c - xb * s, xb * c + xa * s], axis=-2)
    return out.reshape(B, L, H, HEAD_DIM)


def _heads(t, n):
    return t.reshape(t.shape[0], t.shape[1], n, HEAD_DIM)


def _group(q, n_kv):
    B, L, H, D = q.shape
    return q.reshape(B, L, n_kv, H // n_kv, D)


def _global_attention(q, k, v):
    B, L, KV, G, D = q.shape
    nb = L // BLOCK
    scale = 1.0 / math.sqrt(D)
    qb = jnp.moveaxis(q.reshape(B, nb, BLOCK, KV, G, D), 1, 0)

    def block(qblk):
        s = jnp.einsum('bqkgd,bskd->bkgqs', qblk, k).astype(jnp.float32) * scale
        p = jax.nn.softmax(s, axis=-1).astype(v.dtype)
        return jnp.einsum('bkgqs,bskd->bqkgd', p, v)

    out = lax.map(block, qb)
    return jnp.moveaxis(out, 0, 1).reshape(B, L, KV * G * D)


def _sink_softmax(s, sink):
    B, K, G, Q, _ = s.shape
    sk = jnp.broadcast_to(sink.astype(jnp.float32).reshape(1, K, G, 1, 1), (B, K, G, Q, 1))
    return jax.nn.softmax(jnp.concatenate([s, sk], axis=-1), axis=-1)[..., :-1]


def _window_attention(q, k, v, k_ctx, v_ctx, sink):
    B, L, KV, G, D = q.shape
    nb = L // BLOCK
    band = BLOCK + 2 * WINDOW
    n_ctx = k_ctx.shape[1]
    scale = 1.0 / math.sqrt(D)
    pad = ((0, 0), (WINDOW, WINDOW), (0, 0), (0, 0))
    kp, vp = jnp.pad(k, pad), jnp.pad(v, pad)
    qb = jnp.moveaxis(q.reshape(B, nb, BLOCK, KV, G, D), 1, 0)

    def block(args):
        qblk, i = args
        start = i * BLOCK
        kb = lax.dynamic_slice_in_dim(kp, start, band, axis=1)
        vb = lax.dynamic_slice_in_dim(vp, start, band, axis=1)
        qpos = start + jnp.arange(BLOCK)
        kpos = start - WINDOW + jnp.arange(band)
        valid = ((jnp.abs(qpos[:, None] - kpos[None, :]) <= WINDOW)
                 & (kpos >= 0)[None, :] & (kpos < L)[None, :])
        s_c = jnp.einsum('bqkgd,bskd->bkgqs', qblk, k_ctx).astype(jnp.float32) * scale
        s_b = jnp.einsum('bqkgd,bskd->bkgqs', qblk, kb).astype(jnp.float32) * scale
        s_b = jnp.where(valid, s_b, NEG_INF)
        p = _sink_softmax(jnp.concatenate([s_c, s_b], axis=-1), sink).astype(v.dtype)
        return (jnp.einsum('bkgqs,bskd->bqkgd', p[..., :n_ctx], v_ctx)
                + jnp.einsum('bkgqs,bskd->bqkgd', p[..., n_ctx:], vb))

    out = lax.map(block, (qb, jnp.arange(nb)))
    return jnp.moveaxis(out, 0, 1).reshape(B, L, KV * G * D)


def _ctx_sink_attention(q, k, v, sink):
    B, S, KV, G, D = q.shape
    s = jnp.einsum('bqkgd,bskd->bkgqs', q, k).astype(jnp.float32) / math.sqrt(D)
    p = _sink_softmax(s, sink).astype(v.dtype)
    return jnp.einsum('bkgqs,bskd->bqkgd', p, v).reshape(B, S, KV * G * D)


def _hyena_filter_spectrum(L, w1, b1, w2, b2, w3, freq):
    f32 = jnp.float32
    t = jnp.linspace(0.0, 1.0, L, dtype=f32)[:, None]
    bands = jnp.linspace(1e-4, HY_BANDS - 1, HY_BANDS, dtype=f32)
    w = 2.0 * math.pi * jnp.arange(L, dtype=f32)[:, None] / L
    z = jnp.concatenate([t, jnp.cos(bands * w), jnp.sin(bands * w)], axis=-1)
    fr = freq.astype(f32)
    h = jnp.sin(fr[0] * (z @ w1.astype(f32) + b1.astype(f32)))
    h = jnp.sin(fr[1] * (h @ w2.astype(f32) + b2.astype(f32)))
    h = (h @ w3.astype(f32)).reshape(L, HY_ORDER, 2, HY_WIDTH)
    min_decay = math.log(HY_TARGET) / HY_SLOW_DECAY
    max_decay = math.log(HY_TARGET) / HY_FAST_DECAY
    deltas = jnp.linspace(min_decay, max_decay, HY_WIDTH, dtype=f32)
    h = h * jnp.exp(-t * jnp.abs(deltas))[:, None, None, :]
    fwd, bwd = h[:, :, 0], h[:, :, 1]
    filt = jnp.concatenate([fwd, jnp.zeros_like(fwd[:1]), bwd[:0:-1]], axis=0)
    filt = filt / jnp.sum(jnp.abs(filt), axis=0, keepdims=True)
    return jnp.fft.rfft(filt, axis=0)


def _fft_conv(u, spec_o, d_o):
    L = u.shape[1]
    uf = u.astype(jnp.float32)
    y = jnp.fft.irfft(jnp.fft.rfft(uf, n=2 * L, axis=1) * spec_o[None], n=2 * L, axis=1)[:, :L]
    return (y + uf * d_o.astype(jnp.float32)).astype(u.dtype)


def _short_conv(u, w, b):
    L = u.shape[1]
    r = HY_SHORT // 2
    up = jnp.pad(u, ((0, 0), (r, r), (0, 0)))
    out = b
    for j in range(HY_SHORT):
        out = out + up[:, j:j + L] * w[j]
    return out


def _hyena_mixer(v, x1, x2, conv_w, conv_b, spec, d_bias):
    u = _short_conv(jnp.concatenate([v, x1, x2], axis=-1), conv_w, conv_b)
    parts = jnp.split(u, HY_ORDER + 1, axis=-1)
    z = parts[0]
    for o in range(HY_ORDER):
        z = parts[o + 1] * _fft_conv(z, spec[:, o], d_bias[o])
    return z


def _layer(x, ctx, c, c_ctx, norm_g, w_mod, b_mod, w_in, w_out, qn_a, kn_a, qn_c, kn_c, sink_c,
           hy_conv_w, hy_conv_b, hy_w1, hy_b1, hy_w2, hy_b2, hy_w3, hy_freq, hy_bias, last):
    shift, scale, gate = jnp.split(jax.nn.silu(c) @ w_mod + b_mod, 3, axis=-1)
    shift_c, scale_c, gate_c = jnp.split(jax.nn.silu(c_ctx) @ w_mod + b_mod, 3, axis=-1)
    h = _rmsnorm(x, norm_g) * (1 + scale[:, None]) + shift[:, None]
    hc = _rmsnorm(ctx, norm_g) * (1 + scale_c) + shift_c
    aq, ak, av, ag, bv, bx1, bx2, bg, cq, ck, cv, cg = _split_in(h @ w_in)
    off = _in_bounds()
    if last:
        ak_c, av_c = jnp.split(hc @ w_in[:, off[1]:off[3]], 2, axis=-1)
        ck_c, cv_c = jnp.split(hc @ w_in[:, off[9]:off[11]], 2, axis=-1)
    else:
        (aq_c, ak_c, av_c, ag_c, bv_c, bx1_c, bx2_c, bg_c,
         cq_c, ck_c, cv_c, cg_c) = _split_in(hc @ w_in)
    L = x.shape[1]
    cos, sin = _axial_rope_tables(L, x.dtype)
    hy_p = (hy_w1, hy_b1, hy_w2, hy_b2, hy_w3, hy_freq)

    qa = _apply_rope(_rmsnorm(_heads(aq, A_HEADS), qn_a), cos, sin)
    ka = _apply_rope(_rmsnorm(_heads(ak, A_KV_HEADS), kn_a), cos, sin)
    ka_c = _rmsnorm(_heads(ak_c, A_KV_HEADS), kn_a)
    va, va_c = _heads(av, A_KV_HEADS), _heads(av_c, A_KV_HEADS)
    a_out = _global_attention(_group(qa, A_KV_HEADS), jnp.concatenate([ka_c, ka], axis=1),
                              jnp.concatenate([va_c, va], axis=1)) * jax.nn.silu(ag)
    spec = _hyena_filter_spectrum(L, *hy_p)
    b_out = _hyena_mixer(bv, bx1, bx2, hy_conv_w, hy_conv_b, spec, hy_bias) * jax.nn.silu(bg)
    qc = _apply_rope(_rmsnorm(_heads(cq, C_HEADS), qn_c), cos, sin)
    kc = _apply_rope(_rmsnorm(_heads(ck, C_KV_HEADS), kn_c), cos, sin)
    kc_c = _rmsnorm(_heads(ck_c, C_KV_HEADS), kn_c)
    vc, vc_c = _heads(cv, C_KV_HEADS), _heads(cv_c, C_KV_HEADS)
    c_out = _window_attention(_group(qc, C_KV_HEADS), kc, vc, kc_c, vc_c, sink_c) * jax.nn.silu(cg)

    x = x + gate[:, None] * (jnp.concatenate([a_out, b_out, c_out], axis=-1) @ w_out)
    if last:
        return x, None

    qa_c = _group(_rmsnorm(_heads(aq_c, A_HEADS), qn_a), A_KV_HEADS)
    a_c = _global_attention(qa_c, ka_c, va_c) * jax.nn.silu(ag_c)
    spec_c = _hyena_filter_spectrum(ctx.shape[1], *hy_p)
    b_c = _hyena_mixer(bv_c, bx1_c, bx2_c, hy_conv_w, hy_conv_b, spec_c, hy_bias) * jax.nn.silu(bg_c)
    qc_c = _group(_rmsnorm(_heads(cq_c, C_HEADS), qn_c), C_KV_HEADS)
    c_c = _ctx_sink_attention(qc_c, kc_c, vc_c, sink_c) * jax.nn.silu(cg_c)
    ctx = ctx + gate_c * (jnp.concatenate([a_c, b_c, c_c], axis=-1) @ w_out)
    return x, ctx


def setup_inputs(seed: int = 0) -> dict:
    key = jax.random.key(seed)
    ks = jax.random.split(key, 24)
    f32 = jnp.float32

    def nrm(k, shape, s):
        return jax.random.normal(k, shape, f32) * s

    D = D_MODEL
    return {
        "x": nrm(ks[0], (BATCH, SEQ, D), 1.0),
        "c": nrm(ks[1], (BATCH, D), 1.0),
        "ctx": nrm(ks[2], (BATCH, CTX_LEN, D), 1.0),
        "c_ctx": nrm(ks[3], (D,), 1.0),
        "norm_g": 1.0 + nrm(ks[4], (DEPTH, D), 0.1),
        "w_mod": nrm(ks[5], (DEPTH, D, 3 * D), D ** -0.5),
        "b_mod": nrm(ks[6], (DEPTH, 3 * D), 0.02),
        "w_in": nrm(ks[7], (DEPTH, D, IN_WIDTH), D ** -0.5),
        "w_out": nrm(ks[8], (DEPTH, MIX_WIDTH, D), MIX_WIDTH ** -0.5),
        "qn_a": 1.0 + nrm(ks[9], (DEPTH, HEAD_DIM), 0.1),
        "kn_a": 1.0 + nrm(ks[10], (DEPTH, HEAD_DIM), 0.1),
        "qn_c": 1.0 + nrm(ks[11], (DEPTH, HEAD_DIM), 0.1),
        "kn_c": 1.0 + nrm(ks[12], (DEPTH, HEAD_DIM), 0.1),
        "sink_c": nrm(ks[13], (DEPTH, C_HEADS), 0.5),
        "hy_conv_w": nrm(ks[14], (DEPTH, HY_SHORT, 3 * HY_WIDTH), HY_SHORT ** -0.5),
        "hy_conv_b": nrm(ks[15], (DEPTH, 3 * HY_WIDTH), 0.02),
        "hy_w1": nrm(ks[16], (DEPTH, HY_EMB, HY_HIDDEN), HY_EMB ** -0.5),
        "hy_b1": nrm(ks[17], (DEPTH, HY_HIDDEN), 0.1),
        "hy_w2": nrm(ks[18], (DEPTH, HY_HIDDEN, HY_HIDDEN), HY_HIDDEN ** -0.5),
        "hy_b2": nrm(ks[19], (DEPTH, HY_HIDDEN), 0.1),
        "hy_w3": nrm(ks[20], (DEPTH, HY_HIDDEN, HY_ORDER * 2 * HY_WIDTH), HY_HIDDEN ** -0.5),
        "hy_freq": 1.0 + nrm(ks[21], (DEPTH, 2, HY_HIDDEN), 0.1),
        "hy_bias": nrm(ks[22], (DEPTH, HY_ORDER, HY_WIDTH), 0.5),
    }


def reference(x, c, ctx, c_ctx, norm_g, w_mod, b_mod, w_in, w_out, qn_a, kn_a, qn_c, kn_c, sink_c,
              hy_conv_w, hy_conv_b, hy_w1, hy_b1, hy_w2, hy_b2, hy_w3, hy_freq, hy_bias):
    for l in range(DEPTH):
        x, ctx = _layer(x, ctx, c, c_ctx, norm_g[l], w_mod[l], b_mod[l], w_in[l], w_out[l],
                        qn_a[l], kn_a[l], qn_c[l], kn_c[l], sink_c[l],
                        hy_conv_w[l], hy_conv_b[l], hy_w1[l], hy_b1[l], hy_w2[l], hy_b2[l],
                        hy_w3[l], hy_freq[l], hy_bias[l], last=(l == DEPTH - 1))
    return x
```

```cpp
#include <hip/hip_runtime.h>
#include <hip/hip_cooperative_groups.h>
#include <cstdio>
#include <cstdint>
namespace cg = cooperative_groups;
#ifndef MK_SINGLE
#define MK_SINGLE 1
#endif
#ifndef PH_EN
#define PH_EN 0xff
#endif
#ifndef LAUNDER_ARG
#define LAUNDER_ARG 0
#endif
#ifndef LAUNDER_TID
#define LAUNDER_TID MK_SINGLE
#endif
#ifndef REP_UNIT
#define REP_UNIT 0
#endif
#ifndef REP_PH
#define REP_PH 0
#endif
#ifndef REP_HY
#define REP_HY 0
#endif
#ifndef ATT_THR
#define ATT_THR 4.0f
#endif
#ifndef STAGGER_TICKS
#define STAGGER_TICKS 0
#endif
#ifndef REP_PREP
#define REP_PREP 0
#endif
#ifndef REP_SYNC
#define REP_SYNC 0
#endif
#ifndef PROBE_EXP2X
#define PROBE_EXP2X 0
#endif
namespace pg8 {
#define PG8_LAS __attribute__((address_space(3)))
typedef unsigned short bf16_t;
typedef short bf16x8 __attribute__((ext_vector_type(8)));
typedef float f32x4 __attribute__((ext_vector_type(4)));
typedef unsigned u32x4 __attribute__((ext_vector_type(4)));
constexpr int BM = 256, BK = 64, HALF = 128, HTB = HALF * BK * 2  , STAGE_BYTES = 8 * HTB, NXCD = 8, WGM = 4;

__host__ __device__ __forceinline__ int lds_byte(int r, int c) { const int st = (r >> 4) * 2 + (c >> 5), rr = r & 15, cc = c & 31, ob = rr * 64 + cc * 2; return st * 1024 + (ob ^ (((ob >> 9) & 1) << 5)); }
__host__ __device__ __forceinline__ void stage_rc(int b, int& R, int& C) { const int st = b / 1024, sb = b % 1024, swz = sb ^ (((sb >> 9) & 1) << 5); R = (st >> 1) * 16 + swz / 64; C = (st & 1) * 32 + (swz % 64) / 2; }
__host__ __device__ __forceinline__ int perm32(int rho) { const int n = rho >> 4, i = rho & 15; return 8 * (i >> 2) + 4 * n + (i & 3); }

struct Unit { int pm, pn; };
struct Gemm { const bf16_t* A; const bf16_t* Bt; int M, N, K; };

struct StaticOrder {
    int nM, nN, nwg, G, c;
    __host__ __device__ void init(int M, int N, int G_, int c_) { nM = M / BM; nN = N / BM; nwg = nM * nN; G = G_; c = c_; }
    __host__ __device__ bool next(int i, Unit& u) const {
        const long L = (long)i * G + c; if (L >= nwg) return false;
        int wgid = (int)L; { const int q = nwg / NXCD, r = nwg % NXCD, xcd = wgid % NXCD, off = wgid / NXCD; wgid = (xcd < r ? xcd * (q + 1) : r * (q + 1) + (xcd - r) * q) + off; }
        const int nig = WGM * nN, gid = wgid / nig, fm = gid * WGM, gsz = (nM - fm) < WGM ? (nM - fm) : WGM;
        u.pm = fm + ((wgid % nig) % gsz); u.pn = (wgid % nig) / gsz; return true;
    }
    __device__ __forceinline__ void a_ready(const Unit&) const {}
    __device__ __forceinline__ void done(const Unit&) const {}
};

__device__ __forceinline__ unsigned cvt_pk_bf16(float lo, float hi) { unsigned r; asm volatile("v_cvt_pk_bf16_f32 %0, %1, %2" : "=v"(r) : "v"(lo), "v"(hi)); return r; }
typedef float f32x2 __attribute__((ext_vector_type(2)));
__device__ __forceinline__ f32x2 gelu_pk(f32x2 v) {
    const f32x2 av = __builtin_elementwise_abs(v), d = av * 0.2316418882f + 1.0f;
    f32x2 t; t.x = __builtin_amdgcn_rcpf(d.x); t.y = __builtin_amdgcn_rcpf(d.y);
    f32x2 q = t * 0.5307027145f + (-0.7265760135f); q = q * t + 0.7107068705f; q = q * t + (-0.142248368f); q = q * t + 0.127414796f; q = q * t;
    const f32x2 s = (v * v) * (-0.72134752044f);
    f32x2 e; e.x = __builtin_amdgcn_exp2f(s.x); e.y = __builtin_amdgcn_exp2f(s.y);
    const f32x2 m = v * (q * e), r = v - m;
    f32x2 o; o.x = v.x < 0.f ? m.x : r.x; o.y = v.y < 0.f ? m.y : r.y; return o;
}

template <int ACT  > struct EpiBf16 {
    static constexpr bool PERM = true, AFTER_DRAIN = false; static_assert(ACT == 0 || ACT == 1, "EpiBf16: ACT is 0 (none) or 1 (gelu_pk)");
    bf16_t* O; int ldc; const float* bias; int split_cols; size_t split_stride; float scale0;
    __device__ __forceinline__ void operator()(const f32x4 (&acc)[2][2][4][2], const Unit& u, int wr, int wc, int fr, int fq) const {
        const int row0 = u.pm * BM + wr * 64 + fr; int colt = u.pn * BM; bf16_t* base = O;
        float sc = 1.f; if (split_cols) { const int t = colt / split_cols; base += (size_t)t * split_stride; colt -= t * split_cols; if (t == 0) sc = scale0; }
        const int col0 = colt + wc * 32 + 8 * fq, bcol0 = u.pn * BM + wc * 32 + 8 * fq;
        f32x4 bv[2][2];
#pragma unroll
        for (int bj = 0; bj < 2; ++bj)
#pragma unroll
            for (int n = 0; n < 2; ++n) bv[bj][n] = bias ? *(const f32x4*)(bias + bcol0 + bj * HALF + 4 * n) : (f32x4){0.f, 0.f, 0.f, 0.f};
#pragma unroll
        for (int ai = 0; ai < 2; ++ai)
#pragma unroll
            for (int m = 0; m < 4; ++m) { bf16_t* rowp = base + (size_t)(row0 + ai * HALF + m * 16) * ldc + col0;
#pragma unroll
                for (int bj = 0; bj < 2; ++bj) { f32x4 v0 = acc[ai][bj][m][0] + bv[bj][0], v1 = acc[ai][bj][m][1] + bv[bj][1];
                    if (ACT == 1) { f32x2 a = gelu_pk((f32x2){v0[0], v0[1]}), b = gelu_pk((f32x2){v0[2], v0[3]}), c = gelu_pk((f32x2){v1[0], v1[1]}), d = gelu_pk((f32x2){v1[2], v1[3]});
                        v0 = (f32x4){a.x, a.y, b.x, b.y}; v1 = (f32x4){c.x, c.y, d.x, d.y}; }
                    v0 = v0 * sc; v1 = v1 * sc; u32x4 w; w.x = cvt_pk_bf16(v0[0], v0[1]); w.y = cvt_pk_bf16(v0[2], v0[3]); w.z = cvt_pk_bf16(v1[0], v1[1]); w.w = cvt_pk_bf16(v1[2], v1[3]);
                    *(u32x4*)(rowp + bj * HALF) = w; } }
    }
};
template <class Epi, class Sched, bool ALIGN_EPI = false, bool SP2 = false>
__device__ __forceinline__ void gemm_phase(PG8_LAS unsigned char* lds, const Gemm g, const Sched& S, const Epi& E, const int tid_in) {
    const int tid = tid_in, wid = __builtin_amdgcn_readfirstlane(tid >> 6), lane = tid & 63, wr = wid >> 2, wc = wid & 3, fr = lane & 15, fq = lane >> 4;
    const int K = g.K, nt = K / BK;
    unsigned voffA[2], voffB[2];
#pragma unroll
    for (int i = 0; i < 2; ++i) { int R, C; stage_rc(tid * 16 + i * 8192, R, C); const int Rb = Epi::PERM ? ((R & ~31) + perm32(R & 31)) : R;
        voffA[i] = (unsigned)(R * K + C) * 2u; voffB[i] = (unsigned)(Rb * K + C) * 2u; }
    const size_t kstep = (size_t)(BK * 2);
    const size_t hstep = (size_t)HALF * K * 2;
    const size_t tstep = 2 * hstep;
    const unsigned ldsw = (unsigned)wid * 1024u;
    const int aoff = lds_byte(wr * 64 + fr, fq * 8), boff = lds_byte(wc * 32 + fr, fq * 8);
#define PG8_SA(b, h) (((b) * 2 + (h)) * HTB)
#define PG8_SB(b, h) ((4 + (b) * 2 + (h)) * HTB)
#define PG8_STAGE(bufoff, gbase, voff) do { _Pragma("unroll") for (int _i = 0; _i < 2; ++_i) \
        __builtin_amdgcn_global_load_lds((const unsigned*)((const char*)(gbase) + (voff)[_i]), (PG8_LAS unsigned*)(lds + (bufoff) + ldsw + _i * 8192), 16, 0, 0); } while (0)
#define PG8_LDA(dst, b, h) do { _Pragma("unroll") for (int m = 0; m < 4; ++m) _Pragma("unroll") for (int k = 0; k < 2; ++k) dst[m][k] = *(const PG8_LAS bf16x8*)(lds + PG8_SA(b, h) + aoff + m * 2048 + k * 1024); } while (0)
#define PG8_LDB(dst, b, h) do { _Pragma("unroll") for (int n = 0; n < 2; ++n) _Pragma("unroll") for (int k = 0; k < 2; ++k) dst[n][k] = *(const PG8_LAS bf16x8*)(lds + PG8_SB(b, h) + boff + n * 2048 + k * 1024); } while (0)
#define PG8_MMA(ai, bj, At, Bt) do { __builtin_amdgcn_s_setprio(1); _Pragma("unroll") for (int m = 0; m < 4; ++m) _Pragma("unroll") for (int n = 0; n < 2; ++n) _Pragma("unroll") for (int k = 0; k < 2; ++k) \
        acc[ai][bj][m][n] = __builtin_amdgcn_mfma_f32_16x16x32_bf16(Bt[n][k], At[m][k], acc[ai][bj][m][n], 0, 0, 0); __builtin_amdgcn_s_setprio(0); } while (0)
#define PG8_WAIT_V(n) asm volatile("s_waitcnt vmcnt(" #n ")" ::: "memory")
#define PG8_WAIT_L(n) asm volatile("s_waitcnt lgkmcnt(" #n ")" ::: "memory")
#define PG8_BAR __builtin_amdgcn_s_barrier()
#define PG8_SCHED __builtin_amdgcn_sched_barrier(0)
    Unit cur, nxt; int ui = 0;
    if (!S.next(0, cur)) return;
    f32x4 acc[2][2][4][2];
#pragma unroll
    for (int a = 0; a < 2; ++a)
#pragma unroll
        for (int b = 0; b < 2; ++b)
#pragma unroll
            for (int m = 0; m < 4; ++m)
#pragma unroll
                for (int n = 0; n < 2; ++n) acc[a][b][m][n] = (f32x4){0.f, 0.f, 0.f, 0.f};
    bf16x8 At[4][2], B0[2][2], B1[2][2];
    const char* cA = (const char*)g.A + (size_t)cur.pm * tstep; const char* cB = (const char*)g.Bt + (size_t)cur.pn * tstep;
    S.a_ready(cur);
    if constexpr (SP2) {
        PG8_STAGE(PG8_SB(0, 0), cB, voffB); PG8_STAGE(PG8_SB(0, 1), cB + hstep, voffB); PG8_STAGE(PG8_SA(0, 0), cA, voffA); PG8_STAGE(PG8_SA(0, 1), cA + hstep, voffA);
        if (wr == 1) PG8_BAR;
        PG8_WAIT_V(2); PG8_BAR;
        PG8_STAGE(PG8_SB(1, 0), cB + kstep, voffB); PG8_STAGE(PG8_SA(1, 0), cA + kstep, voffA); PG8_STAGE(PG8_SB(1, 1), cB + hstep + kstep, voffB);
        PG8_WAIT_V(6); PG8_BAR;
    } else {
        PG8_STAGE(PG8_SB(0, 0), cB, voffB); PG8_STAGE(PG8_SA(0, 0), cA, voffA); PG8_STAGE(PG8_SB(0, 1), cB + hstep, voffB); PG8_STAGE(PG8_SA(0, 1), cA + hstep, voffA);
        if (wr == 1) PG8_BAR;
        PG8_WAIT_V(4); PG8_BAR;
        PG8_STAGE(PG8_SB(1, 0), cB + kstep, voffB); PG8_STAGE(PG8_SA(1, 0), cA + kstep, voffA); PG8_STAGE(PG8_SB(1, 1), cB + hstep + kstep, voffB);
        PG8_WAIT_V(6); PG8_BAR;
    }
    for (;;) {
        const bool has_next = S.next(ui + 1, nxt);
        const char* nA = has_next ? (const char*)g.A + (size_t)nxt.pm * tstep : cA; const char* nB = has_next ? (const char*)g.Bt + (size_t)nxt.pn * tstep : cB;
        for (int t = 0; t < nt; t += 2) {
            const bool last = (t == nt - 2);
            const char* a1 = cA + (size_t)(t + 1) * kstep;
            const char* a2 = last ? nA : cA + (size_t)(t + 2) * kstep; const char* b2 = last ? nB : cB + (size_t)(t + 2) * kstep;
            const char* a3 = a2 + kstep; const char* b3 = b2 + kstep;
            if (last && has_next) S.a_ready(nxt);
            if constexpr (SP2) {
            PG8_LDB(B0, 0, 0); PG8_LDB(B1, 0, 1); PG8_SCHED; PG8_LDA(At, 0, 0); PG8_STAGE(PG8_SA(1, 1), a1 + hstep, voffA);
            PG8_WAIT_V(8); PG8_WAIT_L(0); PG8_BAR; PG8_MMA(0, 0, At, B0); PG8_MMA(0, 1, At, B1); PG8_BAR; PG8_SCHED;
            PG8_LDA(At, 0, 1); PG8_STAGE(PG8_SB(0, 0), b2, voffB); PG8_STAGE(PG8_SB(0, 1), b2 + hstep, voffB); PG8_STAGE(PG8_SA(0, 0), a2, voffA);
            PG8_WAIT_V(8); PG8_WAIT_L(0); PG8_BAR; PG8_MMA(1, 0, At, B0); PG8_MMA(1, 1, At, B1); PG8_BAR; PG8_SCHED;
            PG8_LDB(B0, 1, 0); PG8_LDB(B1, 1, 1); PG8_SCHED; PG8_LDA(At, 1, 0); PG8_STAGE(PG8_SA(0, 1), a2 + hstep, voffA);
            PG8_WAIT_V(8); PG8_WAIT_L(0); PG8_BAR; PG8_MMA(0, 0, At, B0); PG8_MMA(0, 1, At, B1); PG8_BAR; PG8_SCHED;
            PG8_LDA(At, 1, 1); PG8_STAGE(PG8_SB(1, 0), b3, voffB); PG8_STAGE(PG8_SB(1, 1), b3 + hstep, voffB); PG8_STAGE(PG8_SA(1, 0), a3, voffA);
            PG8_WAIT_V(8); PG8_WAIT_L(0); PG8_BAR; PG8_MMA(1, 0, At, B0); PG8_MMA(1, 1, At, B1); PG8_BAR; PG8_SCHED;
            } else {
            PG8_LDB(B0, 0, 0); PG8_SCHED; PG8_LDA(At, 0, 0); PG8_STAGE(PG8_SA(1, 1), a1 + hstep, voffA);
            PG8_WAIT_L(8); PG8_BAR; PG8_WAIT_L(0); PG8_MMA(0, 0, At, B0); PG8_BAR; PG8_SCHED;
            PG8_LDB(B1, 0, 1); PG8_STAGE(PG8_SB(0, 0), b2, voffB);
            PG8_BAR; PG8_WAIT_L(0); PG8_MMA(0, 1, At, B1); PG8_BAR;
            PG8_LDA(At, 0, 1); PG8_STAGE(PG8_SA(0, 0), a2, voffA);
            PG8_BAR; PG8_WAIT_L(0); PG8_MMA(1, 0, At, B0); PG8_BAR; PG8_SCHED;
            PG8_STAGE(PG8_SB(0, 1), b2 + hstep, voffB);
            PG8_WAIT_V(6); PG8_BAR; PG8_MMA(1, 1, At, B1); PG8_BAR;
            PG8_LDB(B0, 1, 0); PG8_SCHED; PG8_LDA(At, 1, 0); PG8_STAGE(PG8_SA(0, 1), a2 + hstep, voffA);
            PG8_WAIT_L(8); PG8_BAR; PG8_WAIT_L(0); PG8_MMA(0, 0, At, B0); PG8_BAR; PG8_SCHED;
            PG8_LDB(B1, 1, 1); PG8_STAGE(PG8_SB(1, 0), b3, voffB);
            PG8_BAR; PG8_WAIT_L(0); PG8_MMA(0, 1, At, B1); PG8_BAR;
            PG8_LDA(At, 1, 1); PG8_STAGE(PG8_SA(1, 0), a3, voffA);
            PG8_BAR; PG8_WAIT_L(0); PG8_MMA(1, 0, At, B0); PG8_BAR; PG8_SCHED;
            PG8_STAGE(PG8_SB(1, 1), b3 + hstep, voffB);
            PG8_WAIT_V(6); PG8_BAR; PG8_MMA(1, 1, At, B1); PG8_BAR;
            }
        }
        if constexpr (ALIGN_EPI) { if (wr == 0) PG8_BAR; }
        if constexpr (!Epi::AFTER_DRAIN) { E(acc, cur, wr, wc, fr, fq); S.done(cur); }
        if (!has_next) break;
#pragma unroll
        for (int a = 0; a < 2; ++a)
#pragma unroll
            for (int b = 0; b < 2; ++b)
#pragma unroll
                for (int m = 0; m < 4; ++m)
#pragma unroll
                    for (int n = 0; n < 2; ++n) acc[a][b][m][n] = (f32x4){0.f, 0.f, 0.f, 0.f};
        cur = nxt; cA = nA; cB = nB; ++ui;
        if constexpr (ALIGN_EPI) { if (wr == 1) PG8_BAR; }
    }
    PG8_WAIT_V(0);
    if constexpr (!ALIGN_EPI) { if (wr == 0) PG8_BAR; }
    PG8_BAR;
    if constexpr (Epi::AFTER_DRAIN) { E.fused(acc, cur, wr, wc, fr, fq, lds, wid, lane); S.done(cur); }
#undef PG8_SA
#undef PG8_SB
#undef PG8_STAGE
#undef PG8_LDA
#undef PG8_LDB
#undef PG8_MMA
#undef PG8_WAIT_V
#undef PG8_WAIT_L
#undef PG8_BAR
#undef PG8_SCHED
}
}

#define LAS __attribute__((address_space(3)))
typedef unsigned short bf16;
typedef short bf16x8 __attribute__((ext_vector_type(8)));
typedef float f32x4 __attribute__((ext_vector_type(4)));
typedef float f32x16 __attribute__((ext_vector_type(16)));
typedef unsigned u32x4 __attribute__((ext_vector_type(4)));
typedef unsigned u32x2 __attribute__((ext_vector_type(2)));

constexpr int NB = 32, SEQ = 2048, DM = 1024, CL = 256, INW = 3072;
constexpr int MLAT = NB * SEQ, MCTX = NB * CL, MTOT = MLAT + MCTX, KEYS = CL + SEQ;
constexpr size_t MiB = 1u << 20;
constexpr size_t WS_MOD = 0;
constexpr size_t WS_FNORM = 896 * 1024;
constexpr size_t WS_XBAR = 920 * 1024;
constexpr size_t WS_ZERO_BYTES = MiB;
constexpr size_t WS_ROPE = 1 * MiB;
constexpr size_t WS_WINT = 2 * MiB;
constexpr size_t WS_WOUTT = 14 * MiB;
constexpr size_t WS_RRAW = 18 * MiB;
constexpr size_t WS_CTX1 = 36 * MiB;
constexpr size_t WS_HN = 68 * MiB;
constexpr size_t WS_PROJ = 212 * MiB;
constexpr size_t WS_QA = 644 * MiB, WS_QC = 698 * MiB;
constexpr size_t WS_KA = 752 * MiB, WS_KC = 770 * MiB;
constexpr size_t WS_VAT = 788 * MiB, WS_VCT = 806 * MiB;
constexpr size_t WS_HU = 824 * MiB;
constexpr size_t WS_Z1 = 968 * MiB;
constexpr size_t WS_END = 1004 * MiB;
constexpr int LDS_BYTES = 135168;
constexpr float LOG2E = 1.4426950408889634f;

struct Params {
    const float *x, *c, *ctx, *c_ctx, *norm_g, *w_mod, *b_mod, *w_in, *w_out, *qn_a, *kn_a, *qn_c, *kn_c, *sink_c,
                *hy_conv_w, *hy_conv_b, *hy_w1, *hy_b1, *hy_w2, *hy_b2, *hy_w3, *hy_freq, *hy_bias;
    float* out; unsigned char* ws; int ph_lo, ph_hi;
};

__device__ __forceinline__ float bf2f(unsigned h) { return __uint_as_float(h << 16); }
typedef float f32x2_t __attribute__((ext_vector_type(2))); typedef __bf16 bf16x2_t __attribute__((ext_vector_type(2)));
__device__ __forceinline__ unsigned pk2(float lo, float hi) { f32x2_t v = {lo, hi}; bf16x2_t b = __builtin_convertvector(v, bf16x2_t); return __builtin_bit_cast(unsigned, b); }
__device__ __forceinline__ void unpack8(u32x4 w, float* v) {
    v[0] = __uint_as_float(w.x << 16); v[1] = __uint_as_float(w.x & 0xffff0000u); v[2] = __uint_as_float(w.y << 16); v[3] = __uint_as_float(w.y & 0xffff0000u);
    v[4] = __uint_as_float(w.z << 16); v[5] = __uint_as_float(w.z & 0xffff0000u); v[6] = __uint_as_float(w.w << 16); v[7] = __uint_as_float(w.w & 0xffff0000u);
}
__device__ __forceinline__ void unpack4(u32x2 w, float* v) {
    v[0] = __uint_as_float(w.x << 16); v[1] = __uint_as_float(w.x & 0xffff0000u); v[2] = __uint_as_float(w.y << 16); v[3] = __uint_as_float(w.y & 0xffff0000u);
}
__device__ __forceinline__ float silu_f(float v) { return v * __builtin_amdgcn_rcpf(1.0f + __expf(-v)); }
__device__ __forceinline__ float wave_sum(float v) {
#pragma unroll
    for (int o = 1; o < 64; o <<= 1) v += __shfl_xor(v, o);
    return v;
}
__device__ __forceinline__ int crow(int r, int hi) { return (r & 3) + 8 * (r >> 2) + 4 * hi; }

__device__ __forceinline__ void p0_transpose_item(const float* W, int K, int N, bf16* WT, LAS float* scr, int item, int lane) {
    const int nblk = N / 32, kb = item / nblk, nb = item % nblk, k0 = 64 * kb, n0 = 32 * nb;
#pragma unroll 8
    for (int i = 0; i < 32; ++i) { const int kk = 2 * i + (lane >> 5); scr[kk * 33 + (lane & 31)] = W[(size_t)(k0 + kk) * N + n0 + (lane & 31)]; }
    asm volatile("s_waitcnt lgkmcnt(0)" ::: "memory");
    const int c = lane & 7;
#pragma unroll
    for (int j = 0; j < 4; ++j) { const int n = (lane >> 3) + 8 * j; const LAS float* s = scr + (8 * c) * 33 + n;
        u32x4 o; o.x = pk2(s[0 * 33], s[1 * 33]); o.y = pk2(s[2 * 33], s[3 * 33]); o.z = pk2(s[4 * 33], s[5 * 33]); o.w = pk2(s[6 * 33], s[7 * 33]);
        *(u32x4*)(WT + (size_t)(n0 + n) * K + k0 + 8 * c) = o; }
    asm volatile("s_waitcnt lgkmcnt(0)" ::: "memory");
}

__device__ __forceinline__ void p0_filter_unit(const Params& p, LAS unsigned char* lds, int set, int u8, int tid, float asc) {
    const int L = set == 2 ? 256 : 2048, l = set == 1 ? 1 : 0;
    LAS float* zs = (LAS float*)lds; LAS float* h1 = zs + 8 * 36; LAS float* h2 = h1 + 512;
    const int pos = tid >> 6, j = tid & 63, pp = u8 * 8 + pos;
    const float invLm1 = 1.0f / (float)(L - 1);
    if (j < 33) {
        float z;
        if (j == 0) z = (float)pp * invLm1;
        else { const int jb = (j - 1) & 15; const float band = 1e-4f + (float)jb * ((15.0f - 1e-4f) / 15.0f);
               const float w = 6.283185307179586f * (float)pp / (float)L; const float a = band * w; z = (j <= 16) ? __cosf(a) : __sinf(a); }
        zs[pos * 36 + j] = z;
    }
    __syncthreads();
    { float a = p.hy_b1[l * 64 + j]; const float* w1 = p.hy_w1 + (size_t)l * 33 * 64 + j;
      for (int k = 0; k < 33; ++k) a += zs[pos * 36 + k] * w1[k * 64];
      h1[pos * 64 + j] = __sinf(p.hy_freq[l * 128 + j] * a); }
    __syncthreads();
    { float a = p.hy_b2[l * 64 + j]; const float* w2 = p.hy_w2 + (size_t)l * 64 * 64 + j;
      for (int k = 0; k < 64; ++k) a += h1[pos * 64 + k] * w2[k * 64];
      h2[pos * 64 + j] = __sinf(p.hy_freq[l * 128 + 64 + j] * a); }
    __syncthreads();
    float* Rset = (float*)(p.ws + WS_RRAW) + (set == 0 ? 0 : set == 1 ? (size_t)512 * 4096 : (size_t)2 * 512 * 4096);
    float* fnorm = (float*)(p.ws + WS_FNORM) + set * 512;
    const float mind = -3.0701134573253945f, maxd = -15.350567286626973f;
#pragma unroll 1
    for (int half = 0; half < 2; ++half) {
        const int n = tid + 512 * half, o = n >> 9, dir = (n >> 8) & 1, c = n & 255;
        float a[8];
#pragma unroll
        for (int q = 0; q < 8; ++q) a[q] = 0.f;
        const float* w3 = p.hy_w3 + (size_t)l * 64 * 1024 + n;
        for (int k = 0; k < 64; ++k) { const float w = w3[(size_t)k * 1024];
#pragma unroll
            for (int q = 0; q < 8; ++q) a[q] += h2[q * 64 + k] * w; }
        const float delta = fabsf(mind + (float)c * ((maxd - mind) / 255.0f));
        float* R = Rset + (size_t)(o * 256 + c) * (2 * L);
        float s = 0.f;
#pragma unroll
        for (int q = 0; q < 8; ++q) { const int pq = u8 * 8 + q; const float tt = (float)pq * invLm1; const float v = a[q] * __expf(-tt * delta);
            if (dir == 0) { R[L - 1 - pq] = v; s += fabsf(v); } else if (pq >= 1) { R[L - 1 + pq] = v; s += fabsf(v); } }
        __hip_atomic_fetch_add(fnorm + o * 256 + c, s * asc, __ATOMIC_RELAXED, __HIP_MEMORY_SCOPE_AGENT);
    }
    __syncthreads();
}

__device__ __forceinline__ void p0_mod_unit(const Params& p, LAS unsigned char* lds, int u, int tid, float asc) {
    const int l = u / 48, r0 = u % 48, kc = r0 / 6, cgp = r0 % 6;
    LAS float* s = (LAS float*)lds;
    for (int idx = tid; idx < 33 * 128; idx += 512) { const int r = idx >> 7, k = idx & 127;
        const float cv = r < 32 ? p.c[r * 1024 + kc * 128 + k] : p.c_ctx[kc * 128 + k]; s[r * 132 + k] = silu_f(cv); }
    __syncthreads();
    const int j = cgp * 512 + tid;
    float acc[33];
#pragma unroll
    for (int r = 0; r < 33; ++r) acc[r] = 0.f;
    const float* wp = p.w_mod + ((size_t)l * 1024 + kc * 128) * 3072 + j;
#pragma unroll 2
    for (int k4 = 0; k4 < 32; ++k4) {
        const float w0 = wp[(size_t)(4 * k4) * 3072], w1 = wp[(size_t)(4 * k4 + 1) * 3072], w2 = wp[(size_t)(4 * k4 + 2) * 3072], w3 = wp[(size_t)(4 * k4 + 3) * 3072];
#pragma unroll
        for (int r = 0; r < 33; ++r) { const f32x4 sv = *(const LAS f32x4*)(s + r * 132 + 4 * k4); acc[r] += sv.x * w0 + sv.y * w1 + sv.z * w2 + sv.w * w3; }
    }
    float* mod = (float*)(p.ws + WS_MOD) + (size_t)l * 33 * 3072 + j;
    const float bb = kc == 0 ? p.b_mod[l * 3072 + j] : 0.f;
#pragma unroll
    for (int r = 0; r < 33; ++r) __hip_atomic_fetch_add(mod + (size_t)r * 3072, (acc[r] + bb) * asc, __ATOMIC_RELAXED, __HIP_MEMORY_SCOPE_AGENT);
    __syncthreads();
}

__device__ __forceinline__ void p0_all(const Params& p, LAS unsigned char* lds, int tid, int lane, int wave, int G, float asc) {
    constexpr int NU_F = 544, NU_M = 96, NU_R = 128;
    for (int u = blockIdx.x; u < NU_F + NU_M + NU_R; u += G) {
        if (u < NU_F) { const int set = u < 256 ? 0 : u < 512 ? 1 : 2; p0_filter_unit(p, lds, set, u - (set == 0 ? 0 : set == 1 ? 256 : 512), tid, asc); }
        else if (u < NU_F + NU_M) p0_mod_unit(p, lds, u - NU_F, tid, asc);
        else { const int idx = (u - NU_F - NU_M) * 512 + tid, pos = idx >> 5, j = idx & 31, ax = j >> 4, f = j & 15;
               const float invf = exp2f(-(float)f * (13.287712379549449f / 16.0f)); const float pv = ax == 0 ? (float)(pos >> 6) : (float)(pos & 63);
               const float ang = pv * invf; float* ct = (float*)(p.ws + WS_ROPE); ct[idx] = __cosf(ang); ct[2048 * 32 + idx] = __sinf(ang); }
    }
    __syncthreads();
    LAS float* scr = (LAS float*)(lds + wave * 16384);
    const int gw = blockIdx.x * 8 + wave, ngw = G * 8;
    for (int it = gw; it < 4096; it += ngw) {
        const int l = it >> 11, r = it & 2047;
        if (r < 1536) p0_transpose_item(p.w_in + (size_t)l * 1024 * 3072, 1024, 3072, (bf16*)(p.ws + WS_WINT) + (size_t)l * 3072 * 1024, scr, r, lane);
        else p0_transpose_item(p.w_out + (size_t)l * 1024 * 1024, 1024, 1024, (bf16*)(p.ws + WS_WOUTT) + (size_t)l * 1024 * 1024, scr, r - 1536, lane);
    }
}

__device__ __forceinline__ void p1_norm(const Params& p, int l, int lane, int rbeg, int rend, int gw, int ngw) {
    const float* xin = l == 0 ? p.x : p.out; const float* cin = l == 0 ? p.ctx : (const float*)(p.ws + WS_CTX1);
    const float* mod = (const float*)(p.ws + WS_MOD) + (size_t)l * 33 * 3072; const float* g = p.norm_g + l * 1024;
    bf16* HN = (bf16*)(p.ws + WS_HN);
    f32x4 gg[4], sh[4], sc[4]; int bcur = -1;
#pragma unroll
    for (int j = 0; j < 4; ++j) gg[j] = *(const f32x4*)(g + 4 * (lane + 64 * j));
    for (int r0 = rbeg + gw; r0 < rend; r0 += 4 * ngw) {
      f32x4 vv[4][4];
#pragma unroll
      for (int q = 0; q < 4; ++q) { const int r = r0 + q * ngw; if (r < rend) { const float* src = r < MLAT ? xin + (size_t)r * 1024 : cin + (size_t)(r - MLAT) * 1024;
#pragma unroll
          for (int j = 0; j < 4; ++j) vv[q][j] = ((const f32x4*)src)[lane + 64 * j]; } }
#pragma unroll
      for (int q = 0; q < 4; ++q) { const int r = r0 + q * ngw; if (r >= rend) continue;
        const int b = r < MLAT ? (r >> 11) : 32;
        if (b != bcur) { bcur = b; const float* mr = mod + (size_t)b * 3072;
#pragma unroll
            for (int j = 0; j < 4; ++j) { sh[j] = *(const f32x4*)(mr + 4 * (lane + 64 * j)); sc[j] = *(const f32x4*)(mr + 1024 + 4 * (lane + 64 * j)) + 1.0f; } }
        float ss = 0.f;
#pragma unroll
        for (int j = 0; j < 4; ++j) { const f32x4 v = vv[q][j]; ss += (v.x * v.x + v.y * v.y) + (v.z * v.z + v.w * v.w); }
        const float rstd = rsqrtf(wave_sum(ss) * (1.0f / 1024.0f) + 1e-6f);
#pragma unroll
        for (int j = 0; j < 4; ++j) { const int col = 4 * (lane + 64 * j);
            const f32x4 h = vv[q][j] * rstd * gg[j] * sc[j] + sh[j];
            u32x2 w; w.x = pk2(h.x, h.y); w.y = pk2(h.z, h.w); *(u32x2*)(HN + (size_t)r * 1024 + col) = w; }
      }
    }
}

struct EpiResGate {
    static constexpr bool PERM = false, AFTER_DRAIN = false;
    const float* xin; float* out; const float* xin_c; float* out_c; const float* mod;
    __device__ __forceinline__ void operator()(const pg8::f32x4 (&acc)[2][2][4][2], const pg8::Unit& u, int wr, int wc, int fr, int fq) const {
        const int bidx = u.pm < 256 ? (u.pm >> 3) : 32;
        const float* gr = mod + (size_t)bidx * 3072 + 2048 + u.pn * 256 + wc * 32 + fq * 4;
        f32x4 gv[2][2];
#pragma unroll
        for (int bj = 0; bj < 2; ++bj)
#pragma unroll
            for (int n = 0; n < 2; ++n) gv[bj][n] = *(const f32x4*)(gr + bj * 128 + n * 16);
#pragma unroll
        for (int ai = 0; ai < 2; ++ai)
#pragma unroll
            for (int mp = 0; mp < 2; ++mp) {
                f32x4 xv[2][2][2]; float* orow[2];
#pragma unroll
                for (int mm = 0; mm < 2; ++mm) { const int r = u.pm * 256 + ai * 128 + wr * 64 + (2 * mp + mm) * 16 + fr;
                    const float* xr;
                    if (r < MLAT) { xr = xin + (size_t)r * 1024; orow[mm] = out + (size_t)r * 1024; }
                    else { xr = xin_c + (size_t)(r - MLAT) * 1024; orow[mm] = out_c + (size_t)(r - MLAT) * 1024; }
#pragma unroll
                    for (int bj = 0; bj < 2; ++bj)
#pragma unroll
                        for (int n = 0; n < 2; ++n) xv[mm][bj][n] = *(const f32x4*)(xr + u.pn * 256 + bj * 128 + wc * 32 + n * 16 + fq * 4); }
#pragma unroll
                for (int mm = 0; mm < 2; ++mm)
#pragma unroll
                    for (int bj = 0; bj < 2; ++bj)
#pragma unroll
                        for (int n = 0; n < 2; ++n) { const int cidx = u.pn * 256 + bj * 128 + wc * 32 + n * 16 + fq * 4;
                            *(f32x4*)(orow[mm] + cidx) = xv[mm][bj][n] + gv[bj][n] * acc[ai][bj][2 * mp + mm][n]; }
                asm volatile("" ::: "memory");
            }
    }
};

__device__ __forceinline__ void prep_k_pair(const Params& p, int l, int pair, int lane, const u32x4 rawin) {
    const int row = 2 * pair + (lane >> 5), slot = (lane >> 3) & 3, mixer = slot >> 1, hh = slot & 1, dc = lane & 7;
    const bool isctx = row >= MLAT; const int b = isctx ? (row - MLAT) >> 8 : row >> 11; const int t = isctx ? (row - MLAT) & 255 : row & 2047; const int pos = isctx ? t : 256 + t;
    const float* ct = (const float*)(p.ws + WS_ROPE);
    float v[8]; unpack8(rawin, v);
    float ss = 0.f;
#pragma unroll
    for (int j = 0; j < 8; ++j) ss += v[j] * v[j];
    ss += __shfl_xor(ss, 1); ss += __shfl_xor(ss, 2); ss += __shfl_xor(ss, 4);
    const float rstd = rsqrtf(ss * (1.0f / 64.0f) + 1e-6f);
    const float* wn = (mixer ? p.kn_c : p.kn_a) + l * 64 + 8 * dc;
    { const f32x4 w0 = *(const f32x4*)wn, w1 = *(const f32x4*)(wn + 4);
      v[0] *= rstd * w0.x; v[1] *= rstd * w0.y; v[2] *= rstd * w0.z; v[3] *= rstd * w0.w; v[4] *= rstd * w1.x; v[5] *= rstd * w1.y; v[6] *= rstd * w1.z; v[7] *= rstd * w1.w; }
    if (!isctx) {
        const int half = dc >> 2, f0 = 8 * (dc & 1); const bool isA = (dc & 2) == 0;
        const float* cp = ct + (size_t)t * 32 + half * 16 + f0; const float* sp = cp + 2048 * 32;
        const f32x4 c0 = *(const f32x4*)cp, c1 = *(const f32x4*)(cp + 4), s0 = *(const f32x4*)sp, s1 = *(const f32x4*)(sp + 4);
        const float ccv[8] = {c0.x, c0.y, c0.z, c0.w, c1.x, c1.y, c1.z, c1.w}, snv[8] = {s0.x, s0.y, s0.z, s0.w, s1.x, s1.y, s1.z, s1.w};
#pragma unroll
        for (int j = 0; j < 8; ++j) { const float pv = __shfl_xor(v[j], 2); v[j] = isA ? v[j] * ccv[j] - pv * snv[j] : v[j] * ccv[j] + pv * snv[j]; }
    }
    u32x4 o; o.x = pk2(v[0], v[1]); o.y = pk2(v[2], v[3]); o.z = pk2(v[4], v[5]); o.w = pk2(v[6], v[7]);
    bf16* dst = (bf16*)(p.ws + (mixer ? WS_KC : WS_KA)) + ((size_t)(b * 2 + hh) * KEYS + pos) * 64;
    *(u32x4*)(dst + 8 * dc) = o;
}

struct TrJob { int scol, mode, rowbase, seq0, seqlen, pos0; bf16* dst; size_t cstride; };
__device__ __forceinline__ TrJob tr_job(const Params& p, int u) {
    TrJob J; const int job = u & 7, rest = u >> 3, chunk = rest % 18, b = rest / 18;
    const bool isctx = chunk < 2; J.seq0 = isctx ? chunk * 128 : (chunk - 2) * 128; J.seqlen = isctx ? 256 : 2048;
    J.rowbase = isctx ? MLAT + b * 256 : b * 2048; J.pos0 = isctx ? J.seq0 : 256 + J.seq0;
    if (job == 0) { J.scol = 512; J.mode = 0; J.dst = (bf16*)(p.ws + WS_VAT) + (size_t)b * 128 * KEYS; J.cstride = KEYS; }
    else if (job == 1) { J.scol = 2560; J.mode = 0; J.dst = (bf16*)(p.ws + WS_VCT) + (size_t)b * 128 * KEYS; J.cstride = KEYS; }
    else { J.scol = 1024 + 128 * (job - 2); J.mode = job < 6 ? 1 : 3; J.dst = (bf16*)(p.ws + WS_HU) + ((size_t)(128 * (job - 2)) * 32 + b) * KEYS; J.cstride = (size_t)32 * KEYS; }
    return J;
}
__device__ __forceinline__ void tr_load(const Params& p, const TrJob& J, int tid, u32x4 (&raw)[5], u32x4 (&rawg)[4]) {
    const bf16* PROJ = (const bf16*)(p.ws + WS_PROJ);
    if (J.mode == 3) {
#pragma unroll
        for (int q = 0; q < 4; ++q) { const int idx = tid + 512 * q; rawg[q] = *(const u32x4*)(PROJ + (size_t)(J.rowbase + J.seq0 + (idx >> 4)) * INW + J.scol + 256 + 8 * (idx & 15)); } }
#pragma unroll
    for (int q = 0; q < 5; ++q) { const int idx = tid + 512 * q, rr = idx >> 4, t = J.seq0 - 1 + rr;
        raw[q] = (u32x4){0u, 0u, 0u, 0u};
        if (rr < 130 && t >= 0 && t < J.seqlen) raw[q] = *(const u32x4*)(PROJ + (size_t)(J.rowbase + t) * INW + J.scol + 8 * (idx & 15)); }
}
__device__ __forceinline__ void prep_tr_all(const Params& p, LAS unsigned char* lds, int l, int tid, int G) {
    constexpr int NU = 8 * 18 * 32;
    LAS bf16* tile = (LAS bf16*)lds;
    LAS bf16* tileg = tile + 130 * 130;
    int u = blockIdx.x; if (u >= NU) return;
    TrJob J = tr_job(p, u); u32x4 raw[5], rawg[4]; tr_load(p, J, tid, raw, rawg);
    for (;;) {
#pragma unroll
        for (int q = 0; q < 5; ++q) { const int idx = tid + 512 * q, rr = idx >> 4; if (rr < 130) { LAS unsigned* d = (LAS unsigned*)(tile + rr * 130 + 8 * (idx & 15)); d[0] = raw[q].x; d[1] = raw[q].y; d[2] = raw[q].z; d[3] = raw[q].w; } }
        if (J.mode == 3) {
#pragma unroll
            for (int q = 0; q < 4; ++q) { const int idx = tid + 512 * q; LAS unsigned* d = (LAS unsigned*)(tileg + (idx >> 4) * 130 + 8 * (idx & 15)); d[0] = rawg[q].x; d[1] = rawg[q].y; d[2] = rawg[q].z; d[3] = rawg[q].w; } }
        __syncthreads();
        const TrJob C = J; const int un = u + G; const bool more = un < NU;
        if (more) { J = tr_job(p, un); tr_load(p, J, tid, raw, rawg); }
        {
            const int col = tid >> 2, tc = tid & 3;
            float w0 = 0.f, w1 = 1.f, w2 = 0.f, cb = 0.f;
            if (C.mode != 0) { const int ch = C.scol - 1024 + col; const float* cw = p.hy_conv_w + (size_t)l * 3 * 768 + ch; w0 = cw[0]; w1 = cw[768]; w2 = cw[1536]; cb = p.hy_conv_b[l * 768 + ch]; }
            bf16* d = C.dst + (size_t)col * C.cstride + C.pos0 + 32 * tc;
            float prev = bf2f(tile[(32 * tc) * 130 + col]), curv = bf2f(tile[(32 * tc + 1) * 130 + col]);
#pragma unroll
            for (int h4 = 0; h4 < 4; ++h4) { unsigned w[4];
#pragma unroll
                for (int i = 0; i < 4; ++i) { float o2[2];
#pragma unroll
                    for (int e = 0; e < 2; ++e) { const int k = 8 * h4 + 2 * i + e; const float nxt = bf2f(tile[(32 * tc + k + 2) * 130 + col]);
                        float v = cb + w0 * prev + w1 * curv + w2 * nxt; if (C.mode == 3) v *= silu_f(bf2f(tileg[(32 * tc + k) * 130 + col])); o2[e] = v; prev = curv; curv = nxt; }
                    w[i] = pk2(o2[0], o2[1]); }
                *(u32x4*)(d + 8 * h4) = (u32x4){w[0], w[1], w[2], w[3]}; }
        }
        __syncthreads();
        if (!more) break;
        u = un;
    }
}

__device__ __forceinline__ void p2b_prep(const Params& p, LAS unsigned char* lds, int l, int tid, int lane, int wave, int G) {
    const int gw = blockIdx.x * 8 + wave, ngw = G * 8;
    { const bf16* PROJ = (const bf16*)(p.ws + WS_PROJ);
      const int slot = (lane >> 3) & 3, kcol = (slot >> 1) * 2048 + 384 + 64 * (slot & 1) + 8 * (lane & 7);
      for (int i0 = gw; i0 < MTOT / 2; i0 += 4 * ngw) {
          u32x4 raw[4];
#pragma unroll
          for (int q = 0; q < 4; ++q) { const int i = i0 + q * ngw; if (i < MTOT / 2) raw[q] = *(const u32x4*)(PROJ + (size_t)(2 * i + (lane >> 5)) * INW + kcol); }
#pragma unroll
          for (int q = 0; q < 4; ++q) { const int i = i0 + q * ngw; if (i < MTOT / 2) prep_k_pair(p, l, i, lane, raw[q]); }
      } }
    prep_tr_all(p, lds, l, tid, G);
}

template <bool TRACK>
__device__ __forceinline__ void attn_unit(LAS unsigned char* lds, const bf16* Qraw, const float* qnw, const float* ropet, int tpos0, const bf16* Kb, const bf16* Vtb, int n0, int t1lo, int t1hi,
                                          int qstart, bool masked, float m_init, float l_init, const bf16* gate, bf16* outp, int tid, int lane, int wave) {
    const int r32 = lane & 31, hi = lane >> 5;
    const int nt = n0 + (t1hi - t1lo);
    const int srow = tid >> 3, sc = tid & 7;
    u32x4 kreg, vreg;
    { const int tl = 0 < n0 ? 0 : t1lo; kreg = *(const u32x4*)(Kb + (size_t)(tl * 64 + srow) * 64 + sc * 8); vreg = *(const u32x4*)(Vtb + (size_t)srow * KEYS + tl * 64 + sc * 8); }
    bf16x8 qf[4];
    { const int qrow = wave * 32 + r32; const bf16* qp = Qraw + (size_t)qrow * INW + hi * 8;
      float qv[4][8]; float ss = 0.f;
#pragma unroll
      for (int d = 0; d < 4; ++d) { unpack8(*(const u32x4*)(qp + d * 16), qv[d]);
#pragma unroll
          for (int e = 0; e < 8; ++e) ss += qv[d][e] * qv[d][e]; }
      ss += __shfl_xor(ss, 32);
      const float rs = rsqrtf(ss * (1.0f / 64.0f) + 1e-6f) * (0.125f * LOG2E);
#pragma unroll
      for (int d = 0; d < 4; ++d) { const f32x4 w0 = *(const f32x4*)(qnw + d * 16 + hi * 8), w1 = *(const f32x4*)(qnw + d * 16 + hi * 8 + 4);
          qv[d][0] *= rs * w0.x; qv[d][1] *= rs * w0.y; qv[d][2] *= rs * w0.z; qv[d][3] *= rs * w0.w; qv[d][4] *= rs * w1.x; qv[d][5] *= rs * w1.y; qv[d][6] *= rs * w1.z; qv[d][7] *= rs * w1.w; }
      if (tpos0 >= 0) { const float* cp = ropet + (size_t)(tpos0 + qrow) * 32 + hi * 8; const float* sp = cp + 2048 * 32;
#pragma unroll
          for (int ax = 0; ax < 2; ++ax) { const f32x4 c0 = *(const f32x4*)(cp + ax * 16), c1 = *(const f32x4*)(cp + ax * 16 + 4), s0_ = *(const f32x4*)(sp + ax * 16), s1_ = *(const f32x4*)(sp + ax * 16 + 4);
              const float cc[8] = {c0.x, c0.y, c0.z, c0.w, c1.x, c1.y, c1.z, c1.w}, sn[8] = {s0_.x, s0_.y, s0_.z, s0_.w, s1_.x, s1_.y, s1_.z, s1_.w};
#pragma unroll
              for (int e = 0; e < 8; ++e) { const float xa = qv[2 * ax][e], xb = qv[2 * ax + 1][e]; qv[2 * ax][e] = xa * cc[e] - xb * sn[e]; qv[2 * ax + 1][e] = xb * cc[e] + xa * sn[e]; } } }
#pragma unroll
      for (int d = 0; d < 4; ++d) { u32x4 w; w.x = pk2(qv[d][0], qv[d][1]); w.y = pk2(qv[d][2], qv[d][3]); w.z = pk2(qv[d][4], qv[d][5]); w.w = pk2(qv[d][6], qv[d][7]); qf[d] = __builtin_bit_cast(bf16x8, w); } }
    __syncthreads();
    *(LAS u32x4*)(lds + (srow * 72 + sc * 8) * 2) = kreg; { LAS u32x2* vw_ = (LAS u32x2*)(lds + 9216 + (srow * 68 + sc * 8) * 2); vw_[0] = (u32x2){vreg.x, vreg.y}; vw_[1] = (u32x2){vreg.z, vreg.w}; }
    __syncthreads();
    f32x16 o0, o1;
#pragma unroll
    for (int r = 0; r < 16; ++r) { o0[r] = 0.f; o1[r] = 0.f; }
    float m = m_init, lsum = hi == 0 ? l_init : 0.f;
    f32x16 negm, lacc;
#pragma unroll
    for (int r = 0; r < 16; ++r) { negm[r] = TRACK ? -m_init : 0.f; lacc[r] = TRACK ? 0.f : l_init * __builtin_amdgcn_exp2f(m_init); }
    const bf16x8 ones = __builtin_bit_cast(bf16x8, ((u32x4){0x3f803f80u, 0x3f803f80u, 0x3f803f80u, 0x3f803f80u}));
    for (int j = 0; j < nt; ++j) {
        const int cur = j & 1; const int tl = j < n0 ? j : t1lo + (j - n0);
        if (j + 1 < nt) { const int tn = (j + 1) < n0 ? (j + 1) : t1lo + (j + 1 - n0);
            kreg = *(const u32x4*)(Kb + (size_t)(tn * 64 + srow) * 64 + sc * 8); vreg = *(const u32x4*)(Vtb + (size_t)srow * KEYS + tn * 64 + sc * 8); }
        bool active = true; bool mt = masked && j >= n0; const int kpos0 = (tl - 4) * 64;
        if (mt) { const int qs = qstart + wave * 32; active = !(kpos0 > qs + 31 + 128 || kpos0 + 63 < qs - 128);
            if (kpos0 >= qs + 31 - 128 && kpos0 + 63 <= qs + 128) mt = false; }
        if (active) {
            const LAS unsigned char* Kbuf = lds + cur * 18432; const LAS unsigned char* Vbuf = Kbuf + 9216;
            f32x16 s0 = negm, s1 = negm;
            u32x2 vq[8];
            if constexpr (!TRACK) {
            bf16x8 kf[8];
#pragma unroll
            for (int d = 0; d < 4; ++d) { kf[2 * d] = *(const LAS bf16x8*)(Kbuf + (r32 * 72 + d * 16 + hi * 8) * 2); kf[2 * d + 1] = *(const LAS bf16x8*)(Kbuf + ((32 + r32) * 72 + d * 16 + hi * 8) * 2); }
            __builtin_amdgcn_sched_barrier(0);
#pragma unroll
            for (int d = 0; d < 4; ++d) {
                s0 = __builtin_amdgcn_mfma_f32_32x32x16_bf16(kf[2 * d], qf[d], s0, 0, 0, 0);
                s1 = __builtin_amdgcn_mfma_f32_32x32x16_bf16(kf[2 * d + 1], qf[d], s1, 0, 0, 0);
            }
#pragma unroll
            for (int kc = 0; kc < 2; ++kc) {
                const LAS unsigned char* vp0 = Vbuf + (r32 * 68 + kc * 16 + 4 * hi) * 2; const LAS unsigned char* vp1 = vp0 + 32 * 68 * 2;
                vq[4 * kc] = *(const LAS u32x2*)vp0; vq[4 * kc + 1] = *(const LAS u32x2*)(vp0 + 16); vq[4 * kc + 2] = *(const LAS u32x2*)vp1; vq[4 * kc + 3] = *(const LAS u32x2*)(vp1 + 16); }
            __builtin_amdgcn_sched_barrier(0);
            } else {
#pragma unroll
            for (int d = 0; d < 4; ++d) {
                const bf16x8 a0 = *(const LAS bf16x8*)(Kbuf + (r32 * 72 + d * 16 + hi * 8) * 2);
                const bf16x8 a1 = *(const LAS bf16x8*)(Kbuf + ((32 + r32) * 72 + d * 16 + hi * 8) * 2);
                s0 = __builtin_amdgcn_mfma_f32_32x32x16_bf16(a0, qf[d], s0, 0, 0, 0);
                s1 = __builtin_amdgcn_mfma_f32_32x32x16_bf16(a1, qf[d], s1, 0, 0, 0);
            }
            }
            if (mt) { const int qpos = qstart + wave * 32 + r32;
#pragma unroll
                for (int r = 0; r < 16; ++r) { const int d0 = qpos - (kpos0 + crow(r, hi)); if (d0 > 128 || d0 < -128) s0[r] = -INFINITY; const int d1 = d0 - 32; if (d1 > 128 || d1 < -128) s1[r] = -INFINITY; } }
            if (TRACK) {
            float mx = fmaxf(fmaxf(s0[0], s1[0]), s0[1]);
#pragma unroll
            for (int r = 1; r < 15; r += 2) mx = fmaxf(fmaxf(mx, s1[r]), fmaxf(fmaxf(s0[r + 1], s1[r + 1]), s0[r + 2 < 16 ? r + 2 : 15]));
            mx = fmaxf(mx, s1[15]);
            mx = fmaxf(mx, __shfl_xor(mx, 32));
            if (__any(mx > ATT_THR)) {
                const float dl = fmaxf(mx, 0.f); m += dl; const float alpha = __builtin_amdgcn_exp2f(-dl); lsum *= alpha;
#pragma unroll
                for (int r = 0; r < 16; ++r) { s0[r] -= dl; s1[r] -= dl; o0[r] *= alpha; o1[r] *= alpha; negm[r] = -m; }
            }
            float ps = 0.f;
#pragma unroll
            for (int r = 0; r < 16; ++r) { s0[r] = __builtin_amdgcn_exp2f(s0[r]); s1[r] = __builtin_amdgcn_exp2f(s1[r]); ps += s0[r] + s1[r]; }
            lsum += ps;
            } else {
#pragma unroll
            for (int r = 0; r < 16; ++r) { s0[r] = __builtin_amdgcn_exp2f(s0[r]); s1[r] = __builtin_amdgcn_exp2f(s1[r]); }
            }
            bf16x8 pk[4];
            { u32x4 w;
              w.x = pk2(s0[0], s0[1]); w.y = pk2(s0[2], s0[3]); w.z = pk2(s0[4], s0[5]); w.w = pk2(s0[6], s0[7]); pk[0] = __builtin_bit_cast(bf16x8, w);
              w.x = pk2(s0[8], s0[9]); w.y = pk2(s0[10], s0[11]); w.z = pk2(s0[12], s0[13]); w.w = pk2(s0[14], s0[15]); pk[1] = __builtin_bit_cast(bf16x8, w);
              w.x = pk2(s1[0], s1[1]); w.y = pk2(s1[2], s1[3]); w.z = pk2(s1[4], s1[5]); w.w = pk2(s1[6], s1[7]); pk[2] = __builtin_bit_cast(bf16x8, w);
              w.x = pk2(s1[8], s1[9]); w.y = pk2(s1[10], s1[11]); w.z = pk2(s1[12], s1[13]); w.w = pk2(s1[14], s1[15]); pk[3] = __builtin_bit_cast(bf16x8, w); }
#pragma unroll
            for (int kc = 0; kc < 4; ++kc) {
                u32x2 a, bq, c2, d2;
                if (!TRACK && kc < 2) { a = vq[4 * kc]; bq = vq[4 * kc + 1]; c2 = vq[4 * kc + 2]; d2 = vq[4 * kc + 3]; }
                else { const LAS unsigned char* vp0 = Vbuf + (r32 * 68 + kc * 16 + 4 * hi) * 2; const LAS unsigned char* vp1 = vp0 + 32 * 68 * 2;
                    a = *(const LAS u32x2*)vp0; bq = *(const LAS u32x2*)(vp0 + 16); c2 = *(const LAS u32x2*)vp1; d2 = *(const LAS u32x2*)(vp1 + 16); }
                const bf16x8 v0 = __builtin_bit_cast(bf16x8, ((u32x4){a.x, a.y, bq.x, bq.y})), v1 = __builtin_bit_cast(bf16x8, ((u32x4){c2.x, c2.y, d2.x, d2.y}));
                o0 = __builtin_amdgcn_mfma_f32_32x32x16_bf16(v0, pk[kc], o0, 0, 0, 0);
                o1 = __builtin_amdgcn_mfma_f32_32x32x16_bf16(v1, pk[kc], o1, 0, 0, 0);
                if (!TRACK) lacc = __builtin_amdgcn_mfma_f32_32x32x16_bf16(ones, pk[kc], lacc, 0, 0, 0);
            }
        }
        if (j + 1 < nt) { LAS unsigned char* nb = lds + (cur ^ 1) * 18432; *(LAS u32x4*)(nb + (srow * 72 + sc * 8) * 2) = kreg; LAS u32x2* vw_ = (LAS u32x2*)(nb + 9216 + (srow * 68 + sc * 8) * 2); vw_[0] = (u32x2){vreg.x, vreg.y}; vw_[1] = (u32x2){vreg.z, vreg.w}; }
        __syncthreads();
    }
    const float ltot = TRACK ? lsum + __shfl_xor(lsum, 32) : lacc[0]; const float inv = 1.0f / ltot;
    {
        LAS unsigned char* scr = lds + 40960 + wave * 8704;
#pragma unroll
        for (int dh = 0; dh < 2; ++dh)
#pragma unroll
            for (int rg = 0; rg < 4; ++rg) { const int d = dh * 32 + 8 * rg + 4 * hi;
                f32x4 ov; ov.x = (dh == 0 ? o0[4 * rg] : o1[4 * rg]) * inv; ov.y = (dh == 0 ? o0[4 * rg + 1] : o1[4 * rg + 1]) * inv; ov.z = (dh == 0 ? o0[4 * rg + 2] : o1[4 * rg + 2]) * inv; ov.w = (dh == 0 ? o0[4 * rg + 3] : o1[4 * rg + 3]) * inv;
                *(LAS f32x4*)(scr + r32 * 272 + d * 4) = ov; }
        const int pc = lane & 7;
#pragma unroll
        for (int i = 0; i < 4; ++i) { const int rw = i * 8 + (lane >> 3), row = wave * 32 + rw;
            const f32x4 oa = *(const LAS f32x4*)(scr + rw * 272 + pc * 32), ob = *(const LAS f32x4*)(scr + rw * 272 + pc * 32 + 16);
            float gv[8]; unpack8(*(const u32x4*)(gate + (size_t)row * INW + 8 * pc), gv);
            u32x4 w; w.x = pk2(oa.x * silu_f(gv[0]), oa.y * silu_f(gv[1])); w.y = pk2(oa.z * silu_f(gv[2]), oa.w * silu_f(gv[3]));
            w.z = pk2(ob.x * silu_f(gv[4]), ob.y * silu_f(gv[5])); w.w = pk2(ob.z * silu_f(gv[6]), ob.w * silu_f(gv[7]));
            *(u32x4*)(outp + (size_t)row * DM + 8 * pc) = w; }
    }
}

template <int MT, int NP>
__device__ __forceinline__ void hyena_unit(const Params& p, LAS unsigned char* lds, int l, int c, bool isctx, int tid, int lane, int wave, int o_hi = 2) {
    constexpr int L = 256 * MT * NP, CS = 2 * L + 16, NCH = L / 256, IMGB = 8 * CS * 2, BROW = 264, BBUF = 32 * BROW * 2;
    const int posoff = isctx ? 0 : 256, set = isctx ? 2 : l;
    const int r32 = lane & 31, hi = lane >> 5;
    const bf16* HU = (const bf16*)(p.ws + WS_HU); bf16* Z1 = (bf16*)(p.ws + WS_Z1) + (size_t)c * 32 * KEYS;
    bf16* MIX = (bf16*)(p.ws + WS_HN);
    const float* Rset = (const float*)(p.ws + WS_RRAW) + (set == 0 ? 0 : set == 1 ? (size_t)512 * 4096 : (size_t)2 * 512 * 4096);
    const float* fnorm = (const float*)(p.ws + WS_FNORM) + set * 512;
    LAS unsigned char* bb = lds + IMGB;
    const int sb0 = tid >> 5, sp0 = tid & 31;
#pragma unroll 1
    for (int o = 0; o < o_hi; ++o) {
        __syncthreads();
        for (int rep_ = 0; rep_ < 1 + (REP_HY & 1); ++rep_)
        { const float inv = 1.0f / fnorm[o * 256 + c]; const float* Rs = Rset + (size_t)(o * 256 + c) * (2 * L);
          LAS unsigned* img = (LAS unsigned*)lds;
#pragma unroll 4
          for (int idx = tid; idx < 8 * (CS / 2); idx += 512) { const int r = idx / (CS / 2), mp = idx - r * (CS / 2), n = 2 * mp + r;
              const float v0 = n <= 2 * L - 2 ? Rs[n] * inv : 0.f, v1 = n + 1 <= 2 * L - 2 ? Rs[n + 1] * inv : 0.f; img[idx] = pk2(v0, v1); } }
        if (o == 1) { __builtin_amdgcn_fence(__ATOMIC_RELEASE, "workgroup"); __syncthreads(); __builtin_amdgcn_fence(__ATOMIC_ACQUIRE, "agent"); }
        const bf16* Uin = (o == 0 ? HU + (size_t)c * 32 * KEYS : (const bf16*)Z1) + posoff;
        const bf16* Xg = HU + (size_t)((o + 1) * 256 + c) * 32 * KEYS + posoff;
        const float db = p.hy_bias[(l * 2 + o) * 256 + c];
        const int b = r32;
        const int rr = 7 - (r32 & 7);
        { const u32x4 g0 = *(const u32x4*)(Uin + (size_t)sb0 * KEYS + 8 * sp0), g1 = *(const u32x4*)(Uin + (size_t)(sb0 + 16) * KEYS + 8 * sp0);
          *(LAS u32x4*)(bb + (sb0 * BROW + 8 * sp0) * 2) = g0; *(LAS u32x4*)(bb + ((sb0 + 16) * BROW + 8 * sp0) * 2) = g1; }
        __syncthreads();
        int it = 0; constexpr int NRUN = 1 + ((REP_HY >> 1) & 1);
#pragma unroll 1
        for (int pp = 0; pp < NP; ++pp) {
            const int tw = 32 * (pp * 8 + wave) * MT;
            f32x16 acc[MT];
            const LAS unsigned char* ab = lds + (rr * CS + (L - 8 - 8 * (r32 >> 3) + 8 * hi) - tw) * 2;
            bf16x8 aw[2][MT];
#pragma unroll 1
            for (int run = 0; run < NRUN; ++run) {
#pragma unroll
            for (int i = 0; i < MT; ++i)
#pragma unroll
                for (int r = 0; r < 16; ++r) acc[i][r] = 0.f;
#pragma unroll
            for (int kv = 1; kv <= 2 * MT - 2; ++kv) aw[kv & 1][((-kv) >> 1) & (MT - 1)] = *(const LAS bf16x8*)(ab + (-16 * kv) * 2);
#pragma unroll 1
            for (int ch = 0; ch < NCH; ++ch) {
                const int cur = it & 1; const bool more = it + 1 < NP * NCH * NRUN; const int nch = (ch + 1 == NCH) ? 0 : ch + 1; ++it;
                u32x4 g0, g1;
                if (more) { g0 = *(const u32x4*)(Uin + (size_t)sb0 * KEYS + nch * 256 + 8 * sp0); g1 = *(const u32x4*)(Uin + (size_t)(sb0 + 16) * KEYS + nch * 256 + 8 * sp0); }
                const LAS unsigned char* bc = bb + cur * BBUF + (r32 * BROW + 8 * hi) * 2;
                const LAS unsigned char* ac = ab + (ch * 256) * 2;
#pragma unroll
                for (int kk = 0; kk < 16; ++kk) {
                    const int par = kk & 1, s = (kk >> 1) & (MT - 1);
                    aw[par][s] = *(const LAS bf16x8*)(ac + (16 * kk) * 2);
                    const bf16x8 bfr = *(const LAS bf16x8*)(bc + (16 * kk) * 2);
#pragma unroll
                    for (int i = 0; i < MT; ++i) acc[i] = __builtin_amdgcn_mfma_f32_32x32x16_bf16(bfr, aw[par][(s - i) & (MT - 1)], acc[i], 0, 0, 0);
                }
                if (more) { LAS unsigned char* nb = bb + (cur ^ 1) * BBUF; *(LAS u32x4*)(nb + (sb0 * BROW + 8 * sp0) * 2) = g0; *(LAS u32x4*)(nb + ((sb0 + 16) * BROW + 8 * sp0) * 2) = g1; }
                __syncthreads();
            }
            }
            { bf16* Zo = (o == 0 ? Z1 : (bf16*)(p.ws + WS_HU) + (size_t)c * 32 * KEYS) + posoff;
#pragma unroll
              for (int i = 0; i < MT; ++i) { const int t = tw + 32 * i + r32;
                const unsigned off0 = (unsigned)(4 * hi) * KEYS + (unsigned)t;
#pragma unroll
                for (int hf = 0; hf < 2; ++hf) {
                    unsigned uu[8], xx[8];
#pragma unroll
                    for (int q = 0; q < 8; ++q) { const int r = 8 * hf + q; const unsigned off = off0 + (unsigned)((r & 3) + 8 * (r >> 2)) * KEYS; uu[q] = Uin[off]; xx[q] = Xg[off]; }
#pragma unroll
                    for (int q = 0; q < 8; ++q) { const int r = 8 * hf + q; const unsigned off = off0 + (unsigned)((r & 3) + 8 * (r >> 2)) * KEYS;
                        const float z = bf2f(xx[q]) * (acc[i][r] + db * bf2f(uu[q])); Zo[off] = (bf16)(pk2(z, 0.f) & 0xffffu); }
                    asm volatile("" ::: "memory");
                }
              } }
        }
    }
}

template <int PH_EN_T>
__device__ __forceinline__ void p3_mixers(const Params& p, LAS unsigned char* lds, int l, const int tid_in, const int lane_in, int wave, int G) {
    const int tid = tid_in, lane = lane_in;
    const int total = 256 + 1536 + 1536 + (l == 0 ? 256 + 192 + 192 : 0);
    const bf16* PROJ = (const bf16*)(p.ws + WS_PROJ); bf16* MIX = (bf16*)(p.ws + WS_HN);
    bool ntA, ntC;
    { float a = fabsf(p.qn_a[l * 64 + lane]), bq = fabsf(p.kn_a[l * 64 + lane]), cc = fabsf(p.qn_c[l * 64 + lane]), d = fabsf(p.kn_c[l * 64 + lane]);
#pragma unroll
      for (int o = 1; o < 64; o <<= 1) { a = fmaxf(a, __shfl_xor(a, o)); bq = fmaxf(bq, __shfl_xor(bq, o)); cc = fmaxf(cc, __shfl_xor(cc, o)); d = fmaxf(d, __shfl_xor(d, o)); }
      float sk = 0.f;
      for (int h = 0; h < 6; ++h) sk = fmaxf(sk, fabsf(p.sink_c[l * 6 + h]) * LOG2E);
      ntA = 11.6f * a * bq < 60.f; ntC = (11.6f * cc * d < 60.f) && (sk < 60.f); }
    const int tid_ph = tid, lane_ph = lane;
    const int vb = (G % 8 == 0) ? ((int)blockIdx.x % 8) * (G / 8) + (int)blockIdx.x / 8 : (int)blockIdx.x;
    for (int u = vb; u < total; u += G) {
        int tid = tid_ph; asm volatile("" : "+v"(tid)); tid &= 511; const int lane = tid & 63; (void)lane_ph;
        if (u < 256) { if (PH_EN_T & 16) { for (int rep = 0; rep < 1 + (REP_UNIT & 1); ++rep) hyena_unit<4, 2>(p, lds, l, u, false, tid, lane, wave, rep ? 1 : 2); } }
        else if (u < 3328) { if (PH_EN_T & 32) {
            const bool isC = u >= 1792; const int v = u - (isC ? 1792 : 256), b = v / 48, rem = v % 48, h = rem >> 3, qb = rem & 7, kvh = h / 3;
            const float* ropet = (const float*)(p.ws + WS_ROPE); const float* qnw = (isC ? p.qn_c : p.qn_a) + l * 64;
            const bf16* Kb = (const bf16*)(p.ws + (isC ? WS_KC : WS_KA)) + (size_t)(b * 2 + kvh) * KEYS * 64;
            const bf16* Vt = (const bf16*)(p.ws + (isC ? WS_VCT : WS_VAT)) + (size_t)(b * 2 + kvh) * 64 * KEYS;
            const size_t row0 = (size_t)b * 2048 + qb * 256;
            if (!isC) { for (int rep = 0; rep < 1 + ((REP_UNIT >> 1) & 1); ++rep) { if (ntA) attn_unit<false>(lds, PROJ + row0 * INW + h * 64, qnw, ropet, qb * 256, Kb, Vt, 36, 0, 0, 0, false, 0.f, 0.f, PROJ + row0 * INW + 640 + h * 64, MIX + row0 * DM + h * 64, tid, lane, wave);
                else attn_unit<true>(lds, PROJ + row0 * INW + h * 64, qnw, ropet, qb * 256, Kb, Vt, 36, 0, 0, 0, false, 0.f, 0.f, PROJ + row0 * INW + 640 + h * 64, MIX + row0 * DM + h * 64, tid, lane, wave); } }
            else { const int lo = 4 + (4 * qb - 2 > 0 ? 4 * qb - 2 : 0), hi_ = (4 + 4 * qb + 6) < 36 ? (4 + 4 * qb + 6) : 36;
                for (int rep = 0; rep < 1 + ((REP_UNIT >> 2) & 1); ++rep) { if (ntC) attn_unit<false>(lds, PROJ + row0 * INW + 2048 + h * 64, qnw, ropet, qb * 256, Kb, Vt, 4, lo, hi_, qb * 256, true, p.sink_c[l * 6 + h] * LOG2E, 1.f, PROJ + row0 * INW + 2048 + 640 + h * 64, MIX + row0 * DM + 640 + h * 64, tid, lane, wave);
                    else attn_unit<true>(lds, PROJ + row0 * INW + 2048 + h * 64, qnw, ropet, qb * 256, Kb, Vt, 4, lo, hi_, qb * 256, true, p.sink_c[l * 6 + h] * LOG2E, 1.f, PROJ + row0 * INW + 2048 + 640 + h * 64, MIX + row0 * DM + 640 + h * 64, tid, lane, wave); } }
        } } else if (u < 3584) { if (PH_EN_T & 64) hyena_unit<1, 1>(p, lds, l, u - 3328, true, tid, lane, wave); }
        else if (PH_EN_T & 32) {
            const bool isC = u >= 3776; const int v = u - (isC ? 3776 : 3584), b = v / 6, h = v % 6, kvh = h / 3;
            const float* ropet = (const float*)(p.ws + WS_ROPE); const float* qnw = (isC ? p.qn_c : p.qn_a) + l * 64;
            const bf16* Kb = (const bf16*)(p.ws + (isC ? WS_KC : WS_KA)) + (size_t)(b * 2 + kvh) * KEYS * 64;
            const bf16* Vt = (const bf16*)(p.ws + (isC ? WS_VCT : WS_VAT)) + (size_t)(b * 2 + kvh) * 64 * KEYS;
            const size_t row0 = (size_t)MLAT + b * 256;
            if (!isC) { if (ntA) attn_unit<false>(lds, PROJ + row0 * INW + h * 64, qnw, ropet, -1, Kb, Vt, 4, 0, 0, 0, false, 0.f, 0.f, PROJ + row0 * INW + 640 + h * 64, MIX + row0 * DM + h * 64, tid, lane, wave);
                else attn_unit<true>(lds, PROJ + row0 * INW + h * 64, qnw, ropet, -1, Kb, Vt, 4, 0, 0, 0, false, 0.f, 0.f, PROJ + row0 * INW + 640 + h * 64, MIX + row0 * DM + h * 64, tid, lane, wave); }
            else { if (ntC) attn_unit<false>(lds, PROJ + row0 * INW + 2048 + h * 64, qnw, ropet, -1, Kb, Vt, 4, 0, 0, 0, false, p.sink_c[l * 6 + h] * LOG2E, 1.f, PROJ + row0 * INW + 2048 + 640 + h * 64, MIX + row0 * DM + 640 + h * 64, tid, lane, wave);
                else attn_unit<true>(lds, PROJ + row0 * INW + 2048 + h * 64, qnw, ropet, -1, Kb, Vt, 4, 0, 0, 0, false, p.sink_c[l * 6 + h] * LOG2E, 1.f, PROJ + row0 * INW + 2048 + 640 + h * 64, MIX + row0 * DM + 640 + h * 64, tid, lane, wave); }
        }
    }
}

__device__ __forceinline__ void p4_transpose_tile(const Params& p, LAS unsigned char* lds, int pm, int tid) {
    const bf16* HOUT = (const bf16*)(p.ws + WS_HU); bf16* MIX = (bf16*)(p.ws + WS_HN);
    const int b = pm < 256 ? (pm >> 3) : pm - 256, pos0 = pm < 256 ? 256 + (pm & 7) * 256 : 0;
    LAS bf16* tile = (LAS bf16*)lds;
    for (int sub = 0; sub < 4; ++sub) {
        __syncthreads();
#pragma unroll
        for (int q = 0; q < 4; ++q) { const int idx = tid + 512 * q, cc = idx >> 3, pc = idx & 7;
            const u32x4 v = *(const u32x4*)(HOUT + ((size_t)cc * 32 + b) * KEYS + pos0 + sub * 64 + 8 * pc);
            LAS unsigned* d = (LAS unsigned*)(tile + cc * 66 + 8 * pc); d[0] = v.x; d[1] = v.y; d[2] = v.z; d[3] = v.w; }
        __syncthreads();
        const int lane_ = tid & 63, wv_ = tid >> 6;
#pragma unroll
        for (int q = 0; q < 4; ++q) { const int slot = wv_ + 8 * q, t = (slot & 7) * 8 + (lane_ >> 3), piece = (slot >> 3) * 8 + (lane_ & 7), c0 = 8 * piece;
            unsigned w[4];
#pragma unroll
            for (int e = 0; e < 4; ++e) w[e] = (unsigned)tile[(c0 + 2 * e) * 66 + t] | ((unsigned)tile[(c0 + 2 * e + 1) * 66 + t] << 16);
            *(u32x4*)(MIX + (size_t)(256 * pm + sub * 64 + t) * DM + 384 + c0) = (u32x4){w[0], w[1], w[2], w[3]}; }
    }
}
struct RowOrder {
    int c, nM;
    __device__ __forceinline__ bool next(int i, pg8::Unit& u) const {
        if (i < 4) { u.pm = c; u.pn = i; return c < nM; }
        if (i == 4 && nM > 256 && c < 128) { u.pm = 256 + (c >> 2); u.pn = c & 3; return true; }
        return false;
    }
    __device__ __forceinline__ void a_ready(const pg8::Unit&) const {}
    __device__ __forceinline__ void done(const pg8::Unit&) const {}
};

struct InOrder {
    pg8::StaticOrder so; int G, c, ncols;
    __device__ __forceinline__ bool next(int i, pg8::Unit& u) const {
        if (so.next(i, u)) return true;
        const int e = (i - 12) * G + c;
        if (i < 12 || e >= 32 * ncols) return false;
        const int j = e % ncols; u.pm = 256 + e / ncols; u.pn = ncols == 12 ? j : (j < 2 ? 1 + j : 7 + j);
        return true;
    }
    __device__ __forceinline__ void a_ready(const pg8::Unit&) const {}
    __device__ __forceinline__ void done(const pg8::Unit&) const {}
};

#define XB_TMO      128
#define XB_XCNT(j)  (256  + 64 * (j))
#define XB_XSUB(j)  (1280 + 64 * (j))
#define XB_XGEN(j)  (2304 + 64 * (j))
#define XB_TOP      3328
#define XB_TOPGEN   3392
#define XCD_BAR_WORDS 3456
#define XB_SPIN_CAP (1u << 18)

__device__ __forceinline__ unsigned xb_ld(unsigned* p)              { return __hip_atomic_load(p, __ATOMIC_RELAXED, __HIP_MEMORY_SCOPE_AGENT); }
__device__ __forceinline__ unsigned xb_add(unsigned* p, unsigned v) { return __hip_atomic_fetch_add(p, v, __ATOMIC_RELAXED, __HIP_MEMORY_SCOPE_AGENT); }
__device__ __forceinline__ unsigned xb_xcc_id() { return (unsigned)__builtin_amdgcn_s_getreg((3 << 11) | 20) & 0xFu; }
#define XB_SPIN(cond, bar) do { unsigned _sp = 0; while (cond) { __builtin_amdgcn_s_sleep(1); \
    if ((++_sp & 255u) == 0u) { if (xb_ld(&(bar)[XB_TMO])) break; if (_sp > XB_SPIN_CAP) { atomicAdd(&(bar)[XB_TMO], 1u); break; } } } } while (0)

struct XcdBarrier {
    unsigned* bar; unsigned x;
    volatile LAS unsigned* st;
};

__device__ __forceinline__ XcdBarrier xcd_barrier_post(unsigned* bar, volatile LAS unsigned* st) {
    XcdBarrier b; b.bar = bar; b.x = xb_xcc_id(); b.st = st;
    if (threadIdx.x == 0) (void)xb_add(&bar[XB_XCNT(b.x)], 1u);
    return b;
}
__device__ __forceinline__ void xcd_barrier_complete(unsigned* bar, unsigned x, unsigned& nloc, unsigned& nx) {
    const unsigned G = gridDim.x * gridDim.y * gridDim.z;
    unsigned sum, cnt, mine, sp = 0u;
    for (;;) {
        sum = 0u; cnt = 0u; mine = 0u;
#pragma unroll
        for (unsigned j = 0; j < 16; ++j) { const unsigned c = xb_ld(&bar[XB_XCNT(j)]); sum += c; cnt += (c > 0u) ? 1u : 0u; mine = (j == x) ? c : mine; }
        if (sum == G) break;
        __builtin_amdgcn_s_sleep(1);
        if ((++sp & 255u) == 0u) { if (xb_ld(&bar[XB_TMO])) break; if (sp > XB_SPIN_CAP) { atomicAdd(&bar[XB_TMO], 1u); break; } }
    }
    nloc = mine > 0u ? mine : 1u; nx = cnt > 0u ? cnt : 1u;
}

__device__ __forceinline__ void xcd_barrier(const XcdBarrier& b) {
    asm volatile("s_waitcnt vmcnt(0)" ::: "memory");
    __syncthreads();
    if (threadIdx.x == 0) {
        unsigned* bar = b.bar;
        __builtin_amdgcn_s_waitcnt(0);
        unsigned nloc = b.st[0], nx = b.st[1];
        if (nloc == 0u) { xcd_barrier_complete(bar, b.x, nloc, nx); b.st[0] = nloc; b.st[1] = nx; }
        const unsigned old = xb_add(&bar[XB_XSUB(b.x)], 1u);
        const unsigned gen = old / nloc;
        if (old + 1u == (gen + 1u) * nloc) {
            __builtin_amdgcn_fence(__ATOMIC_RELEASE, "agent");
            asm volatile("s_waitcnt vmcnt(0)" ::: "memory");
            const unsigned og = xb_add(&bar[XB_TOP], 1u);
            const unsigned tg = og / nx;
            if (og + 1u == (tg + 1u) * nx) xb_add(&bar[XB_TOPGEN], 1u);
            else XB_SPIN(xb_ld(&bar[XB_TOPGEN]) == tg, bar);
            __builtin_amdgcn_fence(__ATOMIC_ACQUIRE, "agent");
            xb_add(&bar[XB_XGEN(b.x)], 1u);
            asm volatile("s_waitcnt vmcnt(0)" ::: "memory");
        } else {
            XB_SPIN(xb_ld(&bar[XB_XGEN(b.x)]) == gen, bar);
            __builtin_amdgcn_fence(__ATOMIC_ACQUIRE, "agent");
            asm volatile("s_waitcnt vmcnt(0)" ::: "memory");
        }
    }
    __syncthreads();
}

#ifndef PH_EN
#define PH_EN 0xff
#endif
constexpr int N_PHASES = 11;
template <int PH_EN_T>
__global__ void __launch_bounds__(512, 2) mega_fwd(Params p_unused) {
    extern __shared__ __attribute__((aligned(16))) unsigned char lds_raw[];
    LAS unsigned char* lds = (LAS unsigned char*)lds_raw;
#if LAUNDER_ARG
    const Params* kp0 = (const Params*)__builtin_amdgcn_kernarg_segment_ptr();
    int ph_lo, ph_hi; { const Params* q = kp0; asm volatile("" : "+s"(q)); ph_lo = q->ph_lo; ph_hi = q->ph_hi; }
#else
    const int ph_lo = p_unused.ph_lo, ph_hi = p_unused.ph_hi;
#endif
    volatile LAS unsigned* xst = (volatile LAS unsigned*)(lds + 131072 + 2048);
    if (threadIdx.x < 2) xst[threadIdx.x] = 0u;
    __syncthreads();
    unsigned* barw;
#if MK_SINGLE
    { const Params& p0 = p_unused; barw = (unsigned*)(p0.ws + WS_XBAR); }
    XcdBarrier xbar = xcd_barrier_post(barw, xst);
#endif
    int repdone = 0; int nsync = 0;
    for (int ph = ph_lo; ph < ph_hi; ++ph) {
        if (ph == 6) continue;
        if (ph > ph_lo || repdone) {
#if MK_SINGLE
            if (ph_hi > 1000) cg::this_grid().sync();
            xcd_barrier(xbar);
            ++nsync;
#else
            cg::this_grid().sync();
#endif
        }
#if LAUNDER_ARG
        const Params* kq = kp0; asm volatile("" : "+s"(kq) :: "memory");
        const Params& p = *kq;
#else
        const Params& p = p_unused;
#endif
#if LAUNDER_TID
        int tid = threadIdx.x; asm volatile("" : "+v"(tid)); tid &= 511;
#else
        const int tid = threadIdx.x;
#endif
        const int lane = tid & 63, wave = __builtin_amdgcn_readfirstlane(tid >> 6), G = gridDim.x;
        if (ph == 0) { if (PH_EN_T & 1) { p0_all(p, lds, tid, lane, wave, G, 1.0f); if (REP_PH & 1) { __syncthreads(); p0_all(p, lds, tid, lane, wave, G, 0.0f); } } continue; }
        const int l = (ph - 1) / 5, sub = (ph - 1) % 5;
        if (sub == 0) { if (PH_EN_T & 2) { const int per = MTOT / G; p1_norm(p, l, lane, (int)blockIdx.x * per, (int)blockIdx.x * per + per, wave, 8); } }
        else if (sub == 1) { if (PH_EN_T & 4) {
            pg8::Gemm g{(const bf16*)(p.ws + WS_HN), (const bf16*)(p.ws + WS_WINT) + (size_t)l * 3072 * 1024, MTOT, INW, DM};
            if (l == 1 && blockIdx.x < 128) { const int r0 = MLAT + ((int)blockIdx.x >> 2) * 256; p1_norm(p, 1, lane, r0, r0 + 256, wave, 8);
                __builtin_amdgcn_fence(__ATOMIC_RELEASE, "workgroup"); __syncthreads(); __builtin_amdgcn_fence(__ATOMIC_ACQUIRE, "agent"); }
            InOrder S; S.so.init(MLAT, INW, G, (int)blockIdx.x); S.G = G; S.c = (int)blockIdx.x; S.ncols = l == 0 ? 12 : 4;
            pg8::EpiBf16<0> E{(bf16*)(p.ws + WS_PROJ), INW, nullptr, 0, 0, 1.f};
            pg8::gemm_phase<pg8::EpiBf16<0>, InOrder, true, true>(lds, g, S, E, tid);
        } }
        else if (sub == 2) { if (PH_EN_T & 8) p2b_prep(p, lds, l, tid, lane, wave, G); }
        else if (sub == 3) { p3_mixers<PH_EN_T>(p, lds, l, tid, lane, wave, G); }
        else if (PH_EN_T & 128) {
            const int M = l == 0 ? MTOT : MLAT;
            pg8::Gemm g{(const bf16*)(p.ws + WS_HN), (const bf16*)(p.ws + WS_WOUTT) + (size_t)l * 1024 * 1024, M, DM, DM};
            RowOrder S{(int)blockIdx.x, M / 256};
            p4_transpose_tile(p, lds, (int)blockIdx.x, tid);
            if (l == 0 && blockIdx.x < 128) p4_transpose_tile(p, lds, 256 + ((int)blockIdx.x >> 2), tid);
            __builtin_amdgcn_fence(__ATOMIC_RELEASE, "workgroup"); __syncthreads(); __builtin_amdgcn_fence(__ATOMIC_ACQUIRE, "agent");
            EpiResGate E{l == 0 ? p.x : p.out, p.out, p.ctx, (float*)(p.ws + WS_CTX1), (const float*)(p.ws + WS_MOD) + (size_t)l * 33 * 3072};
            pg8::gemm_phase<EpiResGate, RowOrder, true, true>(lds, g, S, E, tid);
            if (l == 0) { __builtin_amdgcn_fence(__ATOMIC_RELEASE, "workgroup"); __syncthreads(); __builtin_amdgcn_fence(__ATOMIC_ACQUIRE, "agent");
                p1_norm(p, 1, lane, 256 * (int)blockIdx.x, 256 * (int)blockIdx.x + 256, wave, 8); }
        }
        if (REP_PH) { if (((REP_PH >> ph) & 1) && !repdone) { repdone = 1; --ph; } else repdone = 0; }
    }
}

extern "C" void kernel_launch(void* const* d_in, const int* in_sizes, int n_in, void* d_out, int out_size, void* d_ws, size_t ws_size, hipStream_t stream) {
    static int grid = 0;
    if (grid == 0) {
        if (n_in != 23 || ws_size < WS_END) { fprintf(stderr, "kernel_launch: unexpected n_in %d / ws_size %zu\n", n_in, ws_size); grid = -1; return; }
        int dev = 0, cus = 0, per_cu = 0;
        hipGetDevice(&dev); hipDeviceGetAttribute(&cus, hipDeviceAttributeMultiprocessorCount, dev);
#if MK_SINGLE
        if (hipFuncSetAttribute((const void*)mega_fwd<PH_EN>, hipFuncAttributeMaxDynamicSharedMemorySize, LDS_BYTES) != hipSuccess) { fprintf(stderr, "hipFuncSetAttribute failed\n"); grid = -1; return; }
        (void)hipOccupancyMaxActiveBlocksPerMultiprocessor(&per_cu, (const void*)mega_fwd<PH_EN>, 512, LDS_BYTES);
        if (per_cu < 1) { fprintf(stderr, "occupancy query: %d blocks per CU\n", per_cu); per_cu = 1; }
#endif
        (void)hipGetLastError();
        grid = cus * 1;
    }
    if (grid < 0) return;
    hipMemsetAsync((char*)d_ws, 0, WS_ZERO_BYTES, stream);
    Params p{};
    const float** pp = (const float**)&p;
    for (int i = 0; i < 23; ++i) pp[i] = (const float*)d_in[i];
    p.out = (float*)d_out; p.ws = (unsigned char*)d_ws;
#if MK_SINGLE
    p.ph_lo = 0; p.ph_hi = N_PHASES;
    void* args[] = {&p};
    hipError_t e = hipLaunchCooperativeKernel((const void*)mega_fwd<PH_EN>, dim3(grid), dim3(512), args, LDS_BYTES, stream);
    if (e != hipSuccess) fprintf(stderr, "cooperative launch failed: %s (grid %d)\n", hipGetErrorString(e), grid);
#else
    static bool attr_done = false;
    if (!attr_done) { attr_done = true;
        (void)hipFuncSetAttribute((const void*)mega_fwd<1>, hipFuncAttributeMaxDynamicSharedMemorySize, LDS_BYTES); (void)hipFuncSetAttribute((const void*)mega_fwd<2>, hipFuncAttributeMaxDynamicSharedMemorySize, LDS_BYTES);
        (void)hipFuncSetAttribute((const void*)mega_fwd<4>, hipFuncAttributeMaxDynamicSharedMemorySize, LDS_BYTES); (void)hipFuncSetAttribute((const void*)mega_fwd<8>, hipFuncAttributeMaxDynamicSharedMemorySize, LDS_BYTES);
        (void)hipFuncSetAttribute((const void*)mega_fwd<112>, hipFuncAttributeMaxDynamicSharedMemorySize, LDS_BYTES); (void)hipFuncSetAttribute((const void*)mega_fwd<128>, hipFuncAttributeMaxDynamicSharedMemorySize, LDS_BYTES); }
    for (int ph = 0; ph < N_PHASES; ++ph) { p.ph_lo = ph; p.ph_hi = ph + 1; const int sub = ph == 0 ? -1 : (ph - 1) % 5;
        if (sub == -1) hipLaunchKernelGGL(mega_fwd<1>, dim3(grid), dim3(512), LDS_BYTES, stream, p);
        else if (sub == 0) hipLaunchKernelGGL(mega_fwd<2>, dim3(grid), dim3(512), LDS_BYTES, stream, p);
        else if (sub == 1) hipLaunchKernelGGL(mega_fwd<4>, dim3(grid), dim3(512), LDS_BYTES, stream, p);
        else if (sub == 2) hipLaunchKernelGGL(mega_fwd<8>, dim3(grid), dim3(512), LDS_BYTES, stream, p);
        else if (sub == 3) hipLaunchKernelGGL(mega_fwd<112>, dim3(grid), dim3(512), LDS_BYTES, stream, p);
        else hipLaunchKernelGGL(mega_fwd<128>, dim3(grid), dim3(512), LDS_BYTES, stream, p); }
#endif
}
```

```cpp
#include <hip/hip_runtime.h>
#include <hip/hip_cooperative_groups.h>
#include <cstdio>
#include <cstdint>
namespace cg = cooperative_groups;
#ifndef MK_SINGLE
#define MK_SINGLE 1
#endif
#ifndef PH_EN
#define PH_EN 0xff
#endif
#ifndef LAUNDER_ARG
#define LAUNDER_ARG 0
#endif
#ifndef LAUNDER_TID
#define LAUNDER_TID MK_SINGLE
#endif
#ifndef REP_UNIT
#define REP_UNIT 0
#endif
#ifndef REP_PH
#define REP_PH 0
#endif
#ifndef REP_HY
#define REP_HY 0
#endif
#ifndef ATT_THR
#define ATT_THR 4.0f
#endif
#ifndef STAGGER_TICKS
#define STAGGER_TICKS 0
#endif
#ifndef REP_PREP
#define REP_PREP 0
#endif
#ifndef REP_SYNC
#define REP_SYNC 0
#endif
#ifndef PROBE_EXP2X
#define PROBE_EXP2X 0
#endif
namespace pg8 {
#define PG8_LAS __attribute__((address_space(3)))
typedef unsigned short bf16_t;
typedef short bf16x8 __attribute__((ext_vector_type(8)));
typedef float f32x4 __attribute__((ext_vector_type(4)));
typedef unsigned u32x4 __attribute__((ext_vector_type(4)));
constexpr int BM = 256, BK = 64, HALF = 128, HTB = HALF * BK * 2  , STAGE_BYTES = 8 * HTB, NXCD = 8, WGM = 4;

__host__ __device__ __forceinline__ int lds_byte(int r, int c) { const int st = (r >> 4) * 2 + (c >> 5), rr = r & 15, cc = c & 31, ob = rr * 64 + cc * 2; return st * 1024 + (ob ^ (((ob >> 9) & 1) << 5)); }
__host__ __device__ __forceinline__ void stage_rc(int b, int& R, int& C) { const int st = b / 1024, sb = b % 1024, swz = sb ^ (((sb >> 9) & 1) << 5); R = (st >> 1) * 16 + swz / 64; C = (st & 1) * 32 + (swz % 64) / 2; }
__host__ __device__ __forceinline__ int perm32(int rho) { const int n = rho >> 4, i = rho & 15; return 8 * (i >> 2) + 4 * n + (i & 3); }

struct Unit { int pm, pn; };
struct Gemm { const bf16_t* A; const bf16_t* Bt; int M, N, K; };

struct StaticOrder {
    int nM, nN, nwg, G, c;
    __host__ __device__ void init(int M, int N, int G_, int c_) { nM = M / BM; nN = N / BM; nwg = nM * nN; G = G_; c = c_; }
    __host__ __device__ bool next(int i, Unit& u) const {
        const long L = (long)i * G + c; if (L >= nwg) return false;
        int wgid = (int)L; { const int q = nwg / NXCD, r = nwg % NXCD, xcd = wgid % NXCD, off = wgid / NXCD; wgid = (xcd < r ? xcd * (q + 1) : r * (q + 1) + (xcd - r) * q) + off; }
        const int nig = WGM * nN, gid = wgid / nig, fm = gid * WGM, gsz = (nM - fm) < WGM ? (nM - fm) : WGM;
        u.pm = fm + ((wgid % nig) % gsz); u.pn = (wgid % nig) / gsz; return true;
    }
    __device__ __forceinline__ void a_ready(const Unit&) const {}
    __device__ __forceinline__ void done(const Unit&) const {}
};

__device__ __forceinline__ unsigned cvt_pk_bf16(float lo, float hi) { unsigned r; asm volatile("v_cvt_pk_bf16_f32 %0, %1, %2" : "=v"(r) : "v"(lo), "v"(hi)); return r; }
typedef float f32x2 __attribute__((ext_vector_type(2)));
__device__ __forceinline__ f32x2 gelu_pk(f32x2 v) {
    const f32x2 av = __builtin_elementwise_abs(v), d = av * 0.2316418882f + 1.0f;
    f32x2 t; t.x = __builtin_amdgcn_rcpf(d.x); t.y = __builtin_amdgcn_rcpf(d.y);
    f32x2 q = t * 0.5307027145f + (-0.7265760135f); q = q * t + 0.7107068705f; q = q * t + (-0.142248368f); q = q * t + 0.127414796f; q = q * t;
    const f32x2 s = (v * v) * (-0.72134752044f);
    f32x2 e; e.x = __builtin_amdgcn_exp2f(s.x); e.y = __builtin_amdgcn_exp2f(s.y);
    const f32x2 m = v * (q * e), r = v - m;
    f32x2 o; o.x = v.x < 0.f ? m.x : r.x; o.y = v.y < 0.f ? m.y : r.y; return o;
}

template <int ACT  > struct EpiBf16 {
    static constexpr bool PERM = true, AFTER_DRAIN = false; static_assert(ACT == 0 || ACT == 1, "EpiBf16: ACT is 0 (none) or 1 (gelu_pk)");
    bf16_t* O; int ldc; const float* bias; int split_cols; size_t split_stride; float scale0;
    __device__ __forceinline__ void operator()(const f32x4 (&acc)[2][2][4][2], const Unit& u, int wr, int wc, int fr, int fq) const {
        const int row0 = u.pm * BM + wr * 64 + fr; int colt = u.pn * BM; bf16_t* base = O;
        float sc = 1.f; if (split_cols) { const int t = colt / split_cols; base += (size_t)t * split_stride; colt -= t * split_cols; if (t == 0) sc = scale0; }
        const int col0 = colt + wc * 32 + 8 * fq, bcol0 = u.pn * BM + wc * 32 + 8 * fq;
        f32x4 bv[2][2];
#pragma unroll
        for (int bj = 0; bj < 2; ++bj)
#pragma unroll
            for (int n = 0; n < 2; ++n) bv[bj][n] = bias ? *(const f32x4*)(bias + bcol0 + bj * HALF + 4 * n) : (f32x4){0.f, 0.f, 0.f, 0.f};
#pragma unroll
        for (int ai = 0; ai < 2; ++ai)
#pragma unroll
            for (int m = 0; m < 4; ++m) { bf16_t* rowp = base + (size_t)(row0 + ai * HALF + m * 16) * ldc + col0;
#pragma unroll
                for (int bj = 0; bj < 2; ++bj) { f32x4 v0 = acc[ai][bj][m][0] + bv[bj][0], v1 = acc[ai][bj][m][1] + bv[bj][1];
                    if (ACT == 1) { f32x2 a = gelu_pk((f32x2){v0[0], v0[1]}), b = gelu_pk((f32x2){v0[2], v0[3]}), c = gelu_pk((f32x2){v1[0], v1[1]}), d = gelu_pk((f32x2){v1[2], v1[3]});
                        v0 = (f32x4){a.x, a.y, b.x, b.y}; v1 = (f32x4){c.x, c.y, d.x, d.y}; }
                    v0 = v0 * sc; v1 = v1 * sc; u32x4 w; w.x = cvt_pk_bf16(v0[0], v0[1]); w.y = cvt_pk_bf16(v0[2], v0[3]); w.z = cvt_pk_bf16(v1[0], v1[1]); w.w = cvt_pk_bf16(v1[2], v1[3]);
                    *(u32x4*)(rowp + bj * HALF) = w; } }
    }
};
template <class Epi, class Sched, bool ALIGN_EPI = false, bool SP2 = false>
__device__ __forceinline__ void gemm_phase(PG8_LAS unsigned char* lds, const Gemm g, const Sched& S, const Epi& E, const int tid_in) {
    const int tid = tid_in, wid = __builtin_amdgcn_readfirstlane(tid >> 6), lane = tid & 63, wr = wid >> 2, wc = wid & 3, fr = lane & 15, fq = lane >> 4;
    const int K = g.K, nt = K / BK;
    unsigned voffA[2], voffB[2];
#pragma unroll
    for (int i = 0; i < 2; ++i) { int R, C; stage_rc(tid * 16 + i * 8192, R, C); const int Rb = Epi::PERM ? ((R & ~31) + perm32(R & 31)) : R;
        voffA[i] = (unsigned)(R * K + C) * 2u; voffB[i] = (unsigned)(Rb * K + C) * 2u; }
    const size_t kstep = (size_t)(BK * 2);
    const size_t hstep = (size_t)HALF * K * 2;
    const size_t tstep = 2 * hstep;
    const unsigned ldsw = (unsigned)wid * 1024u;
    const int aoff = lds_byte(wr * 64 + fr, fq * 8), boff = lds_byte(wc * 32 + fr, fq * 8);
#define PG8_SA(b, h) (((b) * 2 + (h)) * HTB)
#define PG8_SB(b, h) ((4 + (b) * 2 + (h)) * HTB)
#define PG8_STAGE(bufoff, gbase, voff) do { _Pragma("unroll") for (int _i = 0; _i < 2; ++_i) \
        __builtin_amdgcn_global_load_lds((const unsigned*)((const char*)(gbase) + (voff)[_i]), (PG8_LAS unsigned*)(lds + (bufoff) + ldsw + _i * 8192), 16, 0, 0); } while (0)
#define PG8_LDA(dst, b, h) do { _Pragma("unroll") for (int m = 0; m < 4; ++m) _Pragma("unroll") for (int k = 0; k < 2; ++k) dst[m][k] = *(const PG8_LAS bf16x8*)(lds + PG8_SA(b, h) + aoff + m * 2048 + k * 1024); } while (0)
#define PG8_LDB(dst, b, h) do { _Pragma("unroll") for (int n = 0; n < 2; ++n) _Pragma("unroll") for (int k = 0; k < 2; ++k) dst[n][k] = *(const PG8_LAS bf16x8*)(lds + PG8_SB(b, h) + boff + n * 2048 + k * 1024); } while (0)
#define PG8_MMA(ai, bj, At, Bt) do { __builtin_amdgcn_s_setprio(1); _Pragma("unroll") for (int m = 0; m < 4; ++m) _Pragma("unroll") for (int n = 0; n < 2; ++n) _Pragma("unroll") for (int k = 0; k < 2; ++k) \
        acc[ai][bj][m][n] = __builtin_amdgcn_mfma_f32_16x16x32_bf16(Bt[n][k], At[m][k], acc[ai][bj][m][n], 0, 0, 0); __builtin_amdgcn_s_setprio(0); } while (0)
#define PG8_WAIT_V(n) asm volatile("s_waitcnt vmcnt(" #n ")" ::: "memory")
#define PG8_WAIT_L(n) asm volatile("s_waitcnt lgkmcnt(" #n ")" ::: "memory")
#define PG8_BAR __builtin_amdgcn_s_barrier()
#define PG8_SCHED __builtin_amdgcn_sched_barrier(0)
    Unit cur, nxt; int ui = 0;
    if (!S.next(0, cur)) return;
    f32x4 acc[2][2][4][2];
#pragma unroll
    for (int a = 0; a < 2; ++a)
#pragma unroll
        for (int b = 0; b < 2; ++b)
#pragma unroll
            for (int m = 0; m < 4; ++m)
#pragma unroll
                for (int n = 0; n < 2; ++n) acc[a][b][m][n] = (f32x4){0.f, 0.f, 0.f, 0.f};
    bf16x8 At[4][2], B0[2][2], B1[2][2];
    const char* cA = (const char*)g.A + (size_t)cur.pm * tstep; const char* cB = (const char*)g.Bt + (size_t)cur.pn * tstep;
    S.a_ready(cur);
    if constexpr (SP2) {
        PG8_STAGE(PG8_SB(0, 0), cB, voffB); PG8_STAGE(PG8_SB(0, 1), cB + hstep, voffB); PG8_STAGE(PG8_SA(0, 0), cA, voffA); PG8_STAGE(PG8_SA(0, 1), cA + hstep, voffA);
        if (wr == 1) PG8_BAR;
        PG8_WAIT_V(2); PG8_BAR;
        PG8_STAGE(PG8_SB(1, 0), cB + kstep, voffB); PG8_STAGE(PG8_SA(1, 0), cA + kstep, voffA); PG8_STAGE(PG8_SB(1, 1), cB + hstep + kstep, voffB);
        PG8_WAIT_V(6); PG8_BAR;
    } else {
        PG8_STAGE(PG8_SB(0, 0), cB, voffB); PG8_STAGE(PG8_SA(0, 0), cA, voffA); PG8_STAGE(PG8_SB(0, 1), cB + hstep, voffB); PG8_STAGE(PG8_SA(0, 1), cA + hstep, voffA);
        if (wr == 1) PG8_BAR;
        PG8_WAIT_V(4); PG8_BAR;
        PG8_STAGE(PG8_SB(1, 0), cB + kstep, voffB); PG8_STAGE(PG8_SA(1, 0), cA + kstep, voffA); PG8_STAGE(PG8_SB(1, 1), cB + hstep + kstep, voffB);
        PG8_WAIT_V(6); PG8_BAR;
    }
    for (;;) {
        const bool has_next = S.next(ui + 1, nxt);
        const char* nA = has_next ? (const char*)g.A + (size_t)nxt.pm * tstep : cA; const char* nB = has_next ? (const char*)g.Bt + (size_t)nxt.pn * tstep : cB;
        for (int t = 0; t < nt; t += 2) {
            const bool last = (t == nt - 2);
            const char* a1 = cA + (size_t)(t + 1) * kstep;
            const char* a2 = last ? nA : cA + (size_t)(t + 2) * kstep; const char* b2 = last ? nB : cB + (size_t)(t + 2) * kstep;
            const char* a3 = a2 + kstep; const char* b3 = b2 + kstep;
            if (last && has_next) S.a_ready(nxt);
            if constexpr (SP2) {
            PG8_LDB(B0, 0, 0); PG8_LDB(B1, 0, 1); PG8_SCHED; PG8_LDA(At, 0, 0); PG8_STAGE(PG8_SA(1, 1), a1 + hstep, voffA);
            PG8_WAIT_V(8); PG8_WAIT_L(0); PG8_BAR; PG8_MMA(0, 0, At, B0); PG8_MMA(0, 1, At, B1); PG8_BAR; PG8_SCHED;
            PG8_LDA(At, 0, 1); PG8_STAGE(PG8_SB(0, 0), b2, voffB); PG8_STAGE(PG8_SB(0, 1), b2 + hstep, voffB); PG8_STAGE(PG8_SA(0, 0), a2, voffA);
            PG8_WAIT_V(8); PG8_WAIT_L(0); PG8_BAR; PG8_MMA(1, 0, At, B0); PG8_MMA(1, 1, At, B1); PG8_BAR; PG8_SCHED;
            PG8_LDB(B0, 1, 0); PG8_LDB(B1, 1, 1); PG8_SCHED; PG8_LDA(At, 1, 0); PG8_STAGE(PG8_SA(0, 1), a2 + hstep, voffA);
            PG8_WAIT_V(8); PG8_WAIT_L(0); PG8_BAR; PG8_MMA(0, 0, At, B0); PG8_MMA(0, 1, At, B1); PG8_BAR; PG8_SCHED;
            PG8_LDA(At, 1, 1); PG8_STAGE(PG8_SB(1, 0), b3, voffB); PG8_STAGE(PG8_SB(1, 1), b3 + hstep, voffB); PG8_STAGE(PG8_SA(1, 0), a3, voffA);
            PG8_WAIT_V(8); PG8_WAIT_L(0); PG8_BAR; PG8_MMA(1, 0, At, B0); PG8_MMA(1, 1, At, B1); PG8_BAR; PG8_SCHED;
            } else {
            PG8_LDB(B0, 0, 0); PG8_SCHED; PG8_LDA(At, 0, 0); PG8_STAGE(PG8_SA(1, 1), a1 + hstep, voffA);
            PG8_WAIT_L(8); PG8_BAR; PG8_WAIT_L(0); PG8_MMA(0, 0, At, B0); PG8_BAR; PG8_SCHED;
            PG8_LDB(B1, 0, 1); PG8_STAGE(PG8_SB(0, 0), b2, voffB);
            PG8_BAR; PG8_WAIT_L(0); PG8_MMA(0, 1, At, B1); PG8_BAR;
            PG8_LDA(At, 0, 1); PG8_STAGE(PG8_SA(0, 0), a2, voffA);
            PG8_BAR; PG8_WAIT_L(0); PG8_MMA(1, 0, At, B0); PG8_BAR; PG8_SCHED;
            PG8_STAGE(PG8_SB(0, 1), b2 + hstep, voffB);
            PG8_WAIT_V(6); PG8_BAR; PG8_MMA(1, 1, At, B1); PG8_BAR;
            PG8_LDB(B0, 1, 0); PG8_SCHED; PG8_LDA(At, 1, 0); PG8_STAGE(PG8_SA(0, 1), a2 + hstep, voffA);
            PG8_WAIT_L(8); PG8_BAR; PG8_WAIT_L(0); PG8_MMA(0, 0, At, B0); PG8_BAR; PG8_SCHED;
            PG8_LDB(B1, 1, 1); PG8_STAGE(PG8_SB(1, 0), b3, voffB);
            PG8_BAR; PG8_WAIT_L(0); PG8_MMA(0, 1, At, B1); PG8_BAR;
            PG8_LDA(At, 1, 1); PG8_STAGE(PG8_SA(1, 0), a3, voffA);
            PG8_BAR; PG8_WAIT_L(0); PG8_MMA(1, 0, At, B0); PG8_BAR; PG8_SCHED;
            PG8_STAGE(PG8_SB(1, 1), b3 + hstep, voffB);
            PG8_WAIT_V(6); PG8_BAR; PG8_MMA(1, 1, At, B1); PG8_BAR;
            }
        }
        if constexpr (ALIGN_EPI) { if (wr == 0) PG8_BAR; }
        if constexpr (!Epi::AFTER_DRAIN) { E(acc, cur, wr, wc, fr, fq); S.done(cur); }
        if (!has_next) break;
#pragma unroll
        for (int a = 0; a < 2; ++a)
#pragma unroll
            for (int b = 0; b < 2; ++b)
#pragma unroll
                for (int m = 0; m < 4; ++m)
#pragma unroll
                    for (int n = 0; n < 2; ++n) acc[a][b][m][n] = (f32x4){0.f, 0.f, 0.f, 0.f};
        cur = nxt; cA = nA; cB = nB; ++ui;
        if constexpr (ALIGN_EPI) { if (wr == 1) PG8_BAR; }
    }
    PG8_WAIT_V(0);
    if constexpr (!ALIGN_EPI) { if (wr == 0) PG8_BAR; }
    PG8_BAR;
    if constexpr (Epi::AFTER_DRAIN) { E.fused(acc, cur, wr, wc, fr, fq, lds, wid, lane); S.done(cur); }
#undef PG8_SA
#undef PG8_SB
#undef PG8_STAGE
#undef PG8_LDA
#undef PG8_LDB
#undef PG8_MMA
#undef PG8_WAIT_V
#undef PG8_WAIT_L
#undef PG8_BAR
#undef PG8_SCHED
}
}

#define LAS __attribute__((address_space(3)))
typedef unsigned short bf16;
typedef short bf16x8 __attribute__((ext_vector_type(8)));
typedef float f32x4 __attribute__((ext_vector_type(4)));
typedef float f32x16 __attribute__((ext_vector_type(16)));
typedef unsigned u32x4 __attribute__((ext_vector_type(4)));
typedef unsigned u32x2 __attribute__((ext_vector_type(2)));

constexpr int NB = 32, SEQ = 2048, DM = 1024, CL = 256, INW = 3072;
constexpr int MLAT = NB * SEQ, MCTX = NB * CL, MTOT = MLAT + MCTX, KEYS = CL + SEQ;
constexpr size_t MiB = 1u << 20;
constexpr size_t WS_MOD = 0;
constexpr size_t WS_FNORM = 896 * 1024;
constexpr size_t WS_XBAR = 920 * 1024;
constexpr size_t WS_ZERO_BYTES = MiB;
constexpr size_t WS_ROPE = 1 * MiB;
constexpr size_t WS_WINT = 2 * MiB;
constexpr size_t WS_WOUTT = 14 * MiB;
constexpr size_t WS_RRAW = 18 * MiB;
constexpr size_t WS_CTX1 = 36 * MiB;
constexpr size_t WS_HN = 68 * MiB;
constexpr size_t WS_PROJ = 212 * MiB;
constexpr size_t WS_QA = 644 * MiB, WS_QC = 698 * MiB;
constexpr size_t WS_KA = 752 * MiB, WS_KC = 770 * MiB;
constexpr size_t WS_VAT = 788 * MiB, WS_VCT = 806 * MiB;
constexpr size_t WS_HU = 824 * MiB;
constexpr size_t WS_Z1 = 968 * MiB;
constexpr size_t WS_END = 1004 * MiB;
constexpr int LDS_BYTES = 135168;
constexpr float LOG2E = 1.4426950408889634f;

struct Params {
    const float *x, *c, *ctx, *c_ctx, *norm_g, *w_mod, *b_mod, *w_in, *w_out, *qn_a, *kn_a, *qn_c, *kn_c, *sink_c,
                *hy_conv_w, *hy_conv_b, *hy_w1, *hy_b1, *hy_w2, *hy_b2, *hy_w3, *hy_freq, *hy_bias;
    float* out; unsigned char* ws; int ph_lo, ph_hi;
};

__device__ __forceinline__ float bf2f(unsigned h) { return __uint_as_float(h << 16); }
typedef float f32x2_t __attribute__((ext_vector_type(2))); typedef __bf16 bf16x2_t __attribute__((ext_vector_type(2)));
__device__ __forceinline__ unsigned pk2(float lo, float hi) { f32x2_t v = {lo, hi}; bf16x2_t b = __builtin_convertvector(v, bf16x2_t); return __builtin_bit_cast(unsigned, b); }
__device__ __forceinline__ void unpack8(u32x4 w, float* v) {
    v[0] = __uint_as_float(w.x << 16); v[1] = __uint_as_float(w.x & 0xffff0000u); v[2] = __uint_as_float(w.y << 16); v[3] = __uint_as_float(w.y & 0xffff0000u);
    v[4] = __uint_as_float(w.z << 16); v[5] = __uint_as_float(w.z & 0xffff0000u); v[6] = __uint_as_float(w.w << 16); v[7] = __uint_as_float(w.w & 0xffff0000u);
}
__device__ __forceinline__ void unpack4(u32x2 w, float* v) {
    v[0] = __uint_as_float(w.x << 16); v[1] = __uint_as_float(w.x & 0xffff0000u); v[2] = __uint_as_float(w.y << 16); v[3] = __uint_as_float(w.y & 0xffff0000u);
}
__device__ __forceinline__ float silu_f(float v) { return v * __builtin_amdgcn_rcpf(1.0f + __expf(-v)); }
__device__ __forceinline__ float wave_sum(float v) {
#pragma unroll
    for (int o = 1; o < 64; o <<= 1) v += __shfl_xor(v, o);
    return v;
}
__device__ __forceinline__ int crow(int r, int hi) { return (r & 3) + 8 * (r >> 2) + 4 * hi; }

__device__ __forceinline__ void p0_transpose_item(const float* W, int K, int N, bf16* WT, LAS float* scr, int item, int lane) {
    const int nblk = N / 32, kb = item / nblk, nb = item % nblk, k0 = 64 * kb, n0 = 32 * nb;
#pragma unroll 8
    for (int i = 0; i < 32; ++i) { const int kk = 2 * i + (lane >> 5); scr[kk * 33 + (lane & 31)] = W[(size_t)(k0 + kk) * N + n0 + (lane & 31)]; }
    asm volatile("s_waitcnt lgkmcnt(0)" ::: "memory");
    const int c = lane & 7;
#pragma unroll
    for (int j = 0; j < 4; ++j) { const int n = (lane >> 3) + 8 * j; const LAS float* s = scr + (8 * c) * 33 + n;
        u32x4 o; o.x = pk2(s[0 * 33], s[1 * 33]); o.y = pk2(s[2 * 33], s[3 * 33]); o.z = pk2(s[4 * 33], s[5 * 33]); o.w = pk2(s[6 * 33], s[7 * 33]);
        *(u32x4*)(WT + (size_t)(n0 + n) * K + k0 + 8 * c) = o; }
    asm volatile("s_waitcnt lgkmcnt(0)" ::: "memory");
}

__device__ __forceinline__ void p0_filter_unit(const Params& p, LAS unsigned char* lds, int set, int u8, int tid, float asc) {
    const int L = set == 2 ? 256 : 2048, l = set == 1 ? 1 : 0;
    LAS float* zs = (LAS float*)lds; LAS float* h1 = zs + 8 * 36; LAS float* h2 = h1 + 512;
    const int pos = tid >> 6, j = tid & 63, pp = u8 * 8 + pos;
    const float invLm1 = 1.0f / (float)(L - 1);
    if (j < 33) {
        float z;
        if (j == 0) z = (float)pp * invLm1;
        else { const int jb = (j - 1) & 15; const float band = 1e-4f + (float)jb * ((15.0f - 1e-4f) / 15.0f);
               const float w = 6.283185307179586f * (float)pp / (float)L; const float a = band * w; z = (j <= 16) ? __cosf(a) : __sinf(a); }
        zs[pos * 36 + j] = z;
    }
    __syncthreads();
    { float a = p.hy_b1[l * 64 + j]; const float* w1 = p.hy_w1 + (size_t)l * 33 * 64 + j;
      for (int k = 0; k < 33; ++k) a += zs[pos * 36 + k] * w1[k * 64];
      h1[pos * 64 + j] = __sinf(p.hy_freq[l * 128 + j] * a); }
    __syncthreads();
    { float a = p.hy_b2[l * 64 + j]; const float* w2 = p.hy_w2 + (size_t)l * 64 * 64 + j;
      for (int k = 0; k < 64; ++k) a += h1[pos * 64 + k] * w2[k * 64];
      h2[pos * 64 + j] = __sinf(p.hy_freq[l * 128 + 64 + j] * a); }
    __syncthreads();
    float* Rset = (float*)(p.ws + WS_RRAW) + (set == 0 ? 0 : set == 1 ? (size_t)512 * 4096 : (size_t)2 * 512 * 4096);
    float* fnorm = (float*)(p.ws + WS_FNORM) + set * 512;
    const float mind = -3.0701134573253945f, maxd = -15.350567286626973f;
#pragma unroll 1
    for (int half = 0; half < 2; ++half) {
        const int n = tid + 512 * half, o = n >> 9, dir = (n >> 8) & 1, c = n & 255;
        float a[8];
#pragma unroll
        for (int q = 0; q < 8; ++q) a[q] = 0.f;
        const float* w3 = p.hy_w3 + (size_t)l * 64 * 1024 + n;
        for (int k = 0; k < 64; ++k) { const float w = w3[(size_t)k * 1024];
#pragma unroll
            for (int q = 0; q < 8; ++q) a[q] += h2[q * 64 + k] * w; }
        const float delta = fabsf(mind + (float)c * ((maxd - mind) / 255.0f));
        float* R = Rset + (size_t)(o * 256 + c) * (2 * L);
        float s = 0.f;
#pragma unroll
        for (int q = 0; q < 8; ++q) { const int pq = u8 * 8 + q; const float tt = (float)pq * invLm1; const float v = a[q] * __expf(-tt * delta);
            if (dir == 0) { R[L - 1 - pq] = v; s += fabsf(v); } else if (pq >= 1) { R[L - 1 + pq] = v; s += fabsf(v); } }
        __hip_atomic_fetch_add(fnorm + o * 256 + c, s * asc, __ATOMIC_RELAXED, __HIP_MEMORY_SCOPE_AGENT);
    }
    __syncthreads();
}

__device__ __forceinline__ void p0_mod_unit(const Params& p, LAS unsigned char* lds, int u, int tid, float asc) {
    const int l = u / 48, r0 = u % 48, kc = r0 / 6, cgp = r0 % 6;
    LAS float* s = (LAS float*)lds;
    for (int idx = tid; idx < 33 * 128; idx += 512) { const int r = idx >> 7, k = idx & 127;
        const float cv = r < 32 ? p.c[r * 1024 + kc * 128 + k] : p.c_ctx[kc * 128 + k]; s[r * 132 + k] = silu_f(cv); }
    __syncthreads();
    const int j = cgp * 512 + tid;
    float acc[33];
#pragma unroll
    for (int r = 0; r < 33; ++r) acc[r] = 0.f;
    const float* wp = p.w_mod + ((size_t)l * 1024 + kc * 128) * 3072 + j;
#pragma unroll 2
    for (int k4 = 0; k4 < 32; ++k4) {
        const float w0 = wp[(size_t)(4 * k4) * 3072], w1 = wp[(size_t)(4 * k4 + 1) * 3072], w2 = wp[(size_t)(4 * k4 + 2) * 3072], w3 = wp[(size_t)(4 * k4 + 3) * 3072];
#pragma unroll
        for (int r = 0; r < 33; ++r) { const f32x4 sv = *(const LAS f32x4*)(s + r * 132 + 4 * k4); acc[r] += sv.x * w0 + sv.y * w1 + sv.z * w2 + sv.w * w3; }
    }
    float* mod = (float*)(p.ws + WS_MOD) + (size_t)l * 33 * 3072 + j;
    const float bb = kc == 0 ? p.b_mod[l * 3072 + j] : 0.f;
#pragma unroll
    for (int r = 0; r < 33; ++r) __hip_atomic_fetch_add(mod + (size_t)r * 3072, (acc[r] + bb) * asc, __ATOMIC_RELAXED, __HIP_MEMORY_SCOPE_AGENT);
    __syncthreads();
}

__device__ __forceinline__ void p0_all(const Params& p, LAS unsigned char* lds, int tid, int lane, int wave, int G, float asc) {
    constexpr int NU_F = 544, NU_M = 96, NU_R = 128;
    for (int u = blockIdx.x; u < NU_F + NU_M + NU_R; u += G) {
        if (u < NU_F) { const int set = u < 256 ? 0 : u < 512 ? 1 : 2; p0_filter_unit(p, lds, set, u - (set == 0 ? 0 : set == 1 ? 256 : 512), tid, asc); }
        else if (u < NU_F + NU_M) p0_mod_unit(p, lds, u - NU_F, tid, asc);
        else { const int idx = (u - NU_F - NU_M) * 512 + tid, pos = idx >> 5, j = idx & 31, ax = j >> 4, f = j & 15;
               const float invf = exp2f(-(float)f * (13.287712379549449f / 16.0f)); const float pv = ax == 0 ? (float)(pos >> 6) : (float)(pos & 63);
               const float ang = pv * invf; float* ct = (float*)(p.ws + WS_ROPE); ct[idx] = __cosf(ang); ct[2048 * 32 + idx] = __sinf(ang); }
    }
    __syncthreads();
    LAS float* scr = (LAS float*)(lds + wave * 16384);
    const int gw = blockIdx.x * 8 + wave, ngw = G * 8;
    for (int it = gw; it < 4096; it += ngw) {
        const int l = it >> 11, r = it & 2047;
        if (r < 1536) p0_transpose_item(p.w_in + (size_t)l * 1024 * 3072, 1024, 3072, (bf16*)(p.ws + WS_WINT) + (size_t)l * 3072 * 1024, scr, r, lane);
        else p0_transpose_item(p.w_out + (size_t)l * 1024 * 1024, 1024, 1024, (bf16*)(p.ws + WS_WOUTT) + (size_t)l * 1024 * 1024, scr, r - 1536, lane);
    }
}

__device__ __forceinline__ void p1_norm(const Params& p, int l, int lane, int rbeg, int rend, int gw, int ngw) {
    const float* xin = l == 0 ? p.x : p.out; const float* cin = l == 0 ? p.ctx : (const float*)(p.ws + WS_CTX1);
    const float* mod = (const float*)(p.ws + WS_MOD) + (size_t)l * 33 * 3072; const float* g = p.norm_g + l * 1024;
    bf16* HN = (bf16*)(p.ws + WS_HN);
    f32x4 gg[4], sh[4], sc[4]; int bcur = -1;
#pragma unroll
    for (int j = 0; j < 4; ++j) gg[j] = *(const f32x4*)(g + 4 * (lane + 64 * j));
    for (int r0 = rbeg + gw; r0 < rend; r0 += 4 * ngw) {
      f32x4 vv[4][4];
#pragma unroll
      for (int q = 0; q < 4; ++q) { const int r = r0 + q * ngw; if (r < rend) { const float* src = r < MLAT ? xin + (size_t)r * 1024 : cin + (size_t)(r - MLAT) * 1024;
#pragma unroll
          for (int j = 0; j < 4; ++j) vv[q][j] = ((const f32x4*)src)[lane + 64 * j]; } }
#pragma unroll
      for (int q = 0; q < 4; ++q) { const int r = r0 + q * ngw; if (r >= rend) continue;
        const int b = r < MLAT ? (r >> 11) : 32;
        if (b != bcur) { bcur = b; const float* mr = mod + (size_t)b * 3072;
#pragma unroll
            for (int j = 0; j < 4; ++j) { sh[j] = *(const f32x4*)(mr + 4 * (lane + 64 * j)); sc[j] = *(const f32x4*)(mr + 1024 + 4 * (lane + 64 * j)) + 1.0f; } }
        float ss = 0.f;
#pragma unroll
        for (int j = 0; j < 4; ++j) { const f32x4 v = vv[q][j]; ss += (v.x * v.x + v.y * v.y) + (v.z * v.z + v.w * v.w); }
        const float rstd = rsqrtf(wave_sum(ss) * (1.0f / 1024.0f) + 1e-6f);
#pragma unroll
        for (int j = 0; j < 4; ++j) { const int col = 4 * (lane + 64 * j);
            const f32x4 h = vv[q][j] * rstd * gg[j] * sc[j] + sh[j];
            u32x2 w; w.x = pk2(h.x, h.y); w.y = pk2(h.z, h.w); *(u32x2*)(HN + (size_t)r * 1024 + col) = w; }
      }
    }
}

struct EpiResGate {
    static constexpr bool PERM = false, AFTER_DRAIN = false;
    const float* xin; float* out; const float* xin_c; float* out_c; const float* mod;
    __device__ __forceinline__ void operator()(const pg8::f32x4 (&acc)[2][2][4][2], const pg8::Unit& u, int wr, int wc, int fr, int fq) const {
        const int bidx = u.pm < 256 ? (u.pm >> 3) : 32;
        const float* gr = mod + (size_t)bidx * 3072 + 2048 + u.pn * 256 + wc * 32 + fq * 4;
        f32x4 gv[2][2];
#pragma unroll
        for (int bj = 0; bj < 2; ++bj)
#pragma unroll
            for (int n = 0; n < 2; ++n) gv[bj][n] = *(const f32x4*)(gr + bj * 128 + n * 16);
#pragma unroll
        for (int ai = 0; ai < 2; ++ai)
#pragma unroll
            for (int mp = 0; mp < 2; ++mp) {
                f32x4 xv[2][2][2]; float* orow[2];
#pragma unroll
                for (int mm = 0; mm < 2; ++mm) { const int r = u.pm * 256 + ai * 128 + wr * 64 + (2 * mp + mm) * 16 + fr;
                    const float* xr;
                    if (r < MLAT) { xr = xin + (size_t)r * 1024; orow[mm] = out + (size_t)r * 1024; }
                    else { xr = xin_c + (size_t)(r - MLAT) * 1024; orow[mm] = out_c + (size_t)(r - MLAT) * 1024; }
#pragma unroll
                    for (int bj = 0; bj < 2; ++bj)
#pragma unroll
                        for (int n = 0; n < 2; ++n) xv[mm][bj][n] = *(const f32x4*)(xr + u.pn * 256 + bj * 128 + wc * 32 + n * 16 + fq * 4); }
#pragma unroll
                for (int mm = 0; mm < 2; ++mm)
#pragma unroll
                    for (int bj = 0; bj < 2; ++bj)
#pragma unroll
                        for (int n = 0; n < 2; ++n) { const int cidx = u.pn * 256 + bj * 128 + wc * 32 + n * 16 + fq * 4;
                            *(f32x4*)(orow[mm] + cidx) = xv[mm][bj][n] + gv[bj][n] * acc[ai][bj][2 * mp + mm][n]; }
                asm volatile("" ::: "memory");
            }
    }
};

__device__ __forceinline__ void prep_k_pair(const Params& p, int l, int pair, int lane, const u32x4 rawin) {
    const int row = 2 * pair + (lane >> 5), slot = (lane >> 3) & 3, mixer = slot >> 1, hh = slot & 1, dc = lane & 7;
    const bool isctx = row >= MLAT; const int b = isctx ? (row - MLAT) >> 8 : row >> 11; const int t = isctx ? (row - MLAT) & 255 : row & 2047; const int pos = isctx ? t : 256 + t;
    const float* ct = (const float*)(p.ws + WS_ROPE);
    float v[8]; unpack8(rawin, v);
    float ss = 0.f;
#pragma unroll
    for (int j = 0; j < 8; ++j) ss += v[j] * v[j];
    ss += __shfl_xor(ss, 1); ss += __shfl_xor(ss, 2); ss += __shfl_xor(ss, 4);
    const float rstd = rsqrtf(ss * (1.0f / 64.0f) + 1e-6f);
    const float* wn = (mixer ? p.kn_c : p.kn_a) + l * 64 + 8 * dc;
    { const f32x4 w0 = *(const f32x4*)wn, w1 = *(const f32x4*)(wn + 4);
      v[0] *= rstd * w0.x; v[1] *= rstd * w0.y; v[2] *= rstd * w0.z; v[3] *= rstd * w0.w; v[4] *= rstd * w1.x; v[5] *= rstd * w1.y; v[6] *= rstd * w1.z; v[7] *= rstd * w1.w; }
    if (!isctx) {
        const int half = dc >> 2, f0 = 8 * (dc & 1); const bool isA = (dc & 2) == 0;
        const float* cp = ct + (size_t)t * 32 + half * 16 + f0; const float* sp = cp + 2048 * 32;
        const f32x4 c0 = *(const f32x4*)cp, c1 = *(const f32x4*)(cp + 4), s0 = *(const f32x4*)sp, s1 = *(const f32x4*)(sp + 4);
        const float ccv[8] = {c0.x, c0.y, c0.z, c0.w, c1.x, c1.y, c1.z, c1.w}, snv[8] = {s0.x, s0.y, s0.z, s0.w, s1.x, s1.y, s1.z, s1.w};
#pragma unroll
        for (int j = 0; j < 8; ++j) { const float pv = __shfl_xor(v[j], 2); v[j] = isA ? v[j] * ccv[j] - pv * snv[j] : v[j] * ccv[j] + pv * snv[j]; }
    }
    u32x4 o; o.x = pk2(v[0], v[1]); o.y = pk2(v[2], v[3]); o.z = pk2(v[4], v[5]); o.w = pk2(v[6], v[7]);
    bf16* dst = (bf16*)(p.ws + (mixer ? WS_KC : WS_KA)) + ((size_t)(b * 2 + hh) * KEYS + pos) * 64;
    *(u32x4*)(dst + 8 * dc) = o;
}

struct TrJob { int scol, mode, rowbase, seq0, seqlen, pos0; bf16* dst; size_t cstride; };
__device__ __forceinline__ TrJob tr_job(const Params& p, int u) {
    TrJob J; const int job = u & 7, rest = u >> 3, chunk = rest % 18, b = rest / 18;
    const bool isctx = chunk < 2; J.seq0 = isctx ? chunk * 128 : (chunk - 2) * 128; J.seqlen = isctx ? 256 : 2048;
    J.rowbase = isctx ? MLAT + b * 256 : b * 2048; J.pos0 = isctx ? J.seq0 : 256 + J.seq0;
    if (job == 0) { J.scol = 512; J.mode = 0; J.dst = (bf16*)(p.ws + WS_VAT) + (size_t)b * 128 * KEYS; J.cstride = KEYS; }
    else if (job == 1) { J.scol = 2560; J.mode = 0; J.dst = (bf16*)(p.ws + WS_VCT) + (size_t)b * 128 * KEYS; J.cstride = KEYS; }
    else { J.scol = 1024 + 128 * (job - 2); J.mode = job < 6 ? 1 : 3; J.dst = (bf16*)(p.ws + WS_HU) + ((size_t)(128 * (job - 2)) * 32 + b) * KEYS; J.cstride = (size_t)32 * KEYS; }
    return J;
}
__device__ __forceinline__ void tr_load(const Params& p, const TrJob& J, int tid, u32x4 (&raw)[5], u32x4 (&rawg)[4]) {
    const bf16* PROJ = (const bf16*)(p.ws + WS_PROJ);
    if (J.mode == 3) {
#pragma unroll
        for (int q = 0; q < 4; ++q) { const int idx = tid + 512 * q; rawg[q] = *(const u32x4*)(PROJ + (size_t)(J.rowbase + J.seq0 + (idx >> 4)) * INW + J.scol + 256 + 8 * (idx & 15)); } }
#pragma unroll
    for (int q = 0; q < 5; ++q) { const int idx = tid + 512 * q, rr = idx >> 4, t = J.seq0 - 1 + rr;
        raw[q] = (u32x4){0u, 0u, 0u, 0u};
        if (rr < 130 && t >= 0 && t < J.seqlen) raw[q] = *(const u32x4*)(PROJ + (size_t)(J.rowbase + t) * INW + J.scol + 8 * (idx & 15)); }
}
__device__ __forceinline__ void prep_tr_all(const Params& p, LAS unsigned char* lds, int l, int tid, int G) {
    constexpr int NU = 8 * 18 * 32;
    LAS bf16* tile = (LAS bf16*)lds;
    LAS bf16* tileg = tile + 130 * 130;
    int u = blockIdx.x; if (u >= NU) return;
    TrJob J = tr_job(p, u); u32x4 raw[5], rawg[4]; tr_load(p, J, tid, raw, rawg);
    for (;;) {
#pragma unroll
        for (int q = 0; q < 5; ++q) { const int idx = tid + 512 * q, rr = idx >> 4; if (rr < 130) { LAS unsigned* d = (LAS unsigned*)(tile + rr * 130 + 8 * (idx & 15)); d[0] = raw[q].x; d[1] = raw[q].y; d[2] = raw[q].z; d[3] = raw[q].w; } }
        if (J.mode == 3) {
#pragma unroll
            for (int q = 0; q < 4; ++q) { const int idx = tid + 512 * q; LAS unsigned* d = (LAS unsigned*)(tileg + (idx >> 4) * 130 + 8 * (idx & 15)); d[0] = rawg[q].x; d[1] = rawg[q].y; d[2] = rawg[q].z; d[3] = rawg[q].w; } }
        __syncthreads();
        const TrJob C = J; const int un = u + G; const bool more = un < NU;
        if (more) { J = tr_job(p, un); tr_load(p, J, tid, raw, rawg); }
        {
            const int col = tid >> 2, tc = tid & 3;
            float w0 = 0.f, w1 = 1.f, w2 = 0.f, cb = 0.f;
            if (C.mode != 0) { const int ch = C.scol - 1024 + col; const float* cw = p.hy_conv_w + (size_t)l * 3 * 768 + ch; w0 = cw[0]; w1 = cw[768]; w2 = cw[1536]; cb = p.hy_conv_b[l * 768 + ch]; }
            bf16* d = C.dst + (size_t)col * C.cstride + C.pos0 + 32 * tc;
            float prev = bf2f(tile[(32 * tc) * 130 + col]), curv = bf2f(tile[(32 * tc + 1) * 130 + col]);
#pragma unroll
            for (int h4 = 0; h4 < 4; ++h4) { unsigned w[4];
#pragma unroll
                for (int i = 0; i < 4; ++i) { float o2[2];
#pragma unroll
                    for (int e = 0; e < 2; ++e) { const int k = 8 * h4 + 2 * i + e; const float nxt = bf2f(tile[(32 * tc + k + 2) * 130 + col]);
                        float v = cb + w0 * prev + w1 * curv + w2 * nxt; if (C.mode == 3) v *= silu_f(bf2f(tileg[(32 * tc + k) * 130 + col])); o2[e] = v; prev = curv; curv = nxt; }
                    w[i] = pk2(o2[0], o2[1]); }
                *(u32x4*)(d + 8 * h4) = (u32x4){w[0], w[1], w[2], w[3]}; }
        }
        __syncthreads();
        if (!more) break;
        u = un;
    }
}

__device__ __forceinline__ void p2b_prep(const Params& p, LAS unsigned char* lds, int l, int tid, int lane, int wave, int G) {
    const int gw = blockIdx.x * 8 + wave, ngw = G * 8;
    { const bf16* PROJ = (const bf16*)(p.ws + WS_PROJ);
      const int slot = (lane >> 3) & 3, kcol = (slot >> 1) * 2048 + 384 + 64 * (slot & 1) + 8 * (lane & 7);
      for (int i0 = gw; i0 < MTOT / 2; i0 += 4 * ngw) {
          u32x4 raw[4];
#pragma unroll
          for (int q = 0; q < 4; ++q) { const int i = i0 + q * ngw; if (i < MTOT / 2) raw[q] = *(const u32x4*)(PROJ + (size_t)(2 * i + (lane >> 5)) * INW + kcol); }
#pragma unroll
          for (int q = 0; q < 4; ++q) { const int i = i0 + q * ngw; if (i < MTOT / 2) prep_k_pair(p, l, i, lane, raw[q]); }
      } }
    prep_tr_all(p, lds, l, tid, G);
}

template <bool TRACK>
__device__ __forceinline__ void attn_unit(LAS unsigned char* lds, const bf16* Qraw, const float* qnw, const float* ropet, int tpos0, const bf16* Kb, const bf16* Vtb, int n0, int t1lo, int t1hi,
                                          int qstart, bool masked, float m_init, float l_init, const bf16* gate, bf16* outp, int tid, int lane, int wave) {
    const int r32 = lane & 31, hi = lane >> 5;
    const int nt = n0 + (t1hi - t1lo);
    const int srow = tid >> 3, sc = tid & 7;
    u32x4 kreg, vreg;
    { const int tl = 0 < n0 ? 0 : t1lo; kreg = *(const u32x4*)(Kb + (size_t)(tl * 64 + srow) * 64 + sc * 8); vreg = *(const u32x4*)(Vtb + (size_t)srow * KEYS + tl * 64 + sc * 8); }
    bf16x8 qf[4];
    { const int qrow = wave * 32 + r32; const bf16* qp = Qraw + (size_t)qrow * INW + hi * 8;
      float qv[4][8]; float ss = 0.f;
#pragma unroll
      for (int d = 0; d < 4; ++d) { unpack8(*(const u32x4*)(qp + d * 16), qv[d]);
#pragma unroll
          for (int e = 0; e < 8; ++e) ss += qv[d][e] * qv[d][e]; }
      ss += __shfl_xor(ss, 32);
      const float rs = rsqrtf(ss * (1.0f / 64.0f) + 1e-6f) * (0.125f * LOG2E);
#pragma unroll
      for (int d = 0; d < 4; ++d) { const f32x4 w0 = *(const f32x4*)(qnw + d * 16 + hi * 8), w1 = *(const f32x4*)(qnw + d * 16 + hi * 8 + 4);
          qv[d][0] *= rs * w0.x; qv[d][1] *= rs * w0.y; qv[d][2] *= rs * w0.z; qv[d][3] *= rs * w0.w; qv[d][4] *= rs * w1.x; qv[d][5] *= rs * w1.y; qv[d][6] *= rs * w1.z; qv[d][7] *= rs * w1.w; }
      if (tpos0 >= 0) { const float* cp = ropet + (size_t)(tpos0 + qrow) * 32 + hi * 8; const float* sp = cp + 2048 * 32;
#pragma unroll
          for (int ax = 0; ax < 2; ++ax) { const f32x4 c0 = *(const f32x4*)(cp + ax * 16), c1 = *(const f32x4*)(cp + ax * 16 + 4), s0_ = *(const f32x4*)(sp + ax * 16), s1_ = *(const f32x4*)(sp + ax * 16 + 4);
              const float cc[8] = {c0.x, c0.y, c0.z, c0.w, c1.x, c1.y, c1.z, c1.w}, sn[8] = {s0_.x, s0_.y, s0_.z, s0_.w, s1_.x, s1_.y, s1_.z, s1_.w};
#pragma unroll
              for (int e = 0; e < 8; ++e) { const float xa = qv[2 * ax][e], xb = qv[2 * ax + 1][e]; qv[2 * ax][e] = xa * cc[e] - xb * sn[e]; qv[2 * ax + 1][e] = xb * cc[e] + xa * sn[e]; } } }
#pragma unroll
      for (int d = 0; d < 4; ++d) { u32x4 w; w.x = pk2(qv[d][0], qv[d][1]); w.y = pk2(qv[d][2], qv[d][3]); w.z = pk2(qv[d][4], qv[d][5]); w.w = pk2(qv[d][6], qv[d][7]); qf[d] = __builtin_bit_cast(bf16x8, w); } }
    __syncthreads();
    *(LAS u32x4*)(lds + (srow * 72 + sc * 8) * 2) = kreg; { LAS u32x2* vw_ = (LAS u32x2*)(lds + 9216 + (srow * 68 + sc * 8) * 2); vw_[0] = (u32x2){vreg.x, vreg.y}; vw_[1] = (u32x2){vreg.z, vreg.w}; }
    __syncthreads();
    f32x16 o0, o1;
#pragma unroll
    for (int r = 0; r < 16; ++r) { o0[r] = 0.f; o1[r] = 0.f; }
    float m = m_init, lsum = hi == 0 ? l_init : 0.f;
    f32x16 negm, lacc;
#pragma unroll
    for (int r = 0; r < 16; ++r) { negm[r] = TRACK ? -m_init : 0.f; lacc[r] = TRACK ? 0.f : l_init * __builtin_amdgcn_exp2f(m_init); }
    const bf16x8 ones = __builtin_bit_cast(bf16x8, ((u32x4){0x3f803f80u, 0x3f803f80u, 0x3f803f80u, 0x3f803f80u}));
    for (int j = 0; j < nt; ++j) {
        const int cur = j & 1; const int tl = j < n0 ? j : t1lo + (j - n0);
        if (j + 1 < nt) { const int tn = (j + 1) < n0 ? (j + 1) : t1lo + (j + 1 - n0);
            kreg = *(const u32x4*)(Kb + (size_t)(tn * 64 + srow) * 64 + sc * 8); vreg = *(const u32x4*)(Vtb + (size_t)srow * KEYS + tn * 64 + sc * 8); }
        bool active = true; bool mt = masked && j >= n0; const int kpos0 = (tl - 4) * 64;
        if (mt) { const int qs = qstart + wave * 32; active = !(kpos0 > qs + 31 + 128 || kpos0 + 63 < qs - 128);
            if (kpos0 >= qs + 31 - 128 && kpos0 + 63 <= qs + 128) mt = false; }
        if (active) {
            const LAS unsigned char* Kbuf = lds + cur * 18432; const LAS unsigned char* Vbuf = Kbuf + 9216;
            f32x16 s0 = negm, s1 = negm;
            u32x2 vq[8];
            if constexpr (!TRACK) {
            bf16x8 kf[8];
#pragma unroll
            for (int d = 0; d < 4; ++d) { kf[2 * d] = *(const LAS bf16x8*)(Kbuf + (r32 * 72 + d * 16 + hi * 8) * 2); kf[2 * d + 1] = *(const LAS bf16x8*)(Kbuf + ((32 + r32) * 72 + d * 16 + hi * 8) * 2); }
            __builtin_amdgcn_sched_barrier(0);
#pragma unroll
            for (int d = 0; d < 4; ++d) {
                s0 = __builtin_amdgcn_mfma_f32_32x32x16_bf16(kf[2 * d], qf[d], s0, 0, 0, 0);
                s1 = __builtin_amdgcn_mfma_f32_32x32x16_bf16(kf[2 * d + 1], qf[d], s1, 0, 0, 0);
            }
#pragma unroll
            for (int kc = 0; kc < 2; ++kc) {
                const LAS unsigned char* vp0 = Vbuf + (r32 * 68 + kc * 16 + 4 * hi) * 2; const LAS unsigned char* vp1 = vp0 + 32 * 68 * 2;
                vq[4 * kc] = *(const LAS u32x2*)vp0; vq[4 * kc + 1] = *(const LAS u32x2*)(vp0 + 16); vq[4 * kc + 2] = *(const LAS u32x2*)vp1; vq[4 * kc + 3] = *(const LAS u32x2*)(vp1 + 16); }
            __builtin_amdgcn_sched_barrier(0);
            } else {
#pragma unroll
            for (int d = 0; d < 4; ++d) {
                const bf16x8 a0 = *(const LAS bf16x8*)(Kbuf + (r32 * 72 + d * 16 + hi * 8) * 2);
                const bf16x8 a1 = *(const LAS bf16x8*)(Kbuf + ((32 + r32) * 72 + d * 16 + hi * 8) * 2);
                s0 = __builtin_amdgcn_mfma_f32_32x32x16_bf16(a0, qf[d], s0, 0, 0, 0);
                s1 = __builtin_amdgcn_mfma_f32_32x32x16_bf16(a1, qf[d], s1, 0, 0, 0);
            }
            }
            if (mt) { const int qpos = qstart + wave * 32 + r32;
#pragma unroll
                for (int r = 0; r < 16; ++r) { const int d0 = qpos - (kpos0 + crow(r, hi)); if (d0 > 128 || d0 < -128) s0[r] = -INFINITY; const int d1 = d0 - 32; if (d1 > 128 || d1 < -128) s1[r] = -INFINITY; } }
            if (TRACK) {
            float mx = fmaxf(fmaxf(s0[0], s1[0]), s0[1]);
#pragma unroll
            for (int r = 1; r < 15; r += 2) mx = fmaxf(fmaxf(mx, s1[r]), fmaxf(fmaxf(s0[r + 1], s1[r + 1]), s0[r + 2 < 16 ? r + 2 : 15]));
            mx = fmaxf(mx, s1[15]);
            mx = fmaxf(mx, __shfl_xor(mx, 32));
            if (__any(mx > ATT_THR)) {
                const float dl = fmaxf(mx, 0.f); m += dl; const float alpha = __builtin_amdgcn_exp2f(-dl); lsum *= alpha;
#pragma unroll
                for (int r = 0; r < 16; ++r) { s0[r] -= dl; s1[r] -= dl; o0[r] *= alpha; o1[r] *= alpha; negm[r] = -m; }
            }
            float ps = 0.f;
#pragma unroll
            for (int r = 0; r < 16; ++r) { s0[r] = __builtin_amdgcn_exp2f(s0[r]); s1[r] = __builtin_amdgcn_exp2f(s1[r]); ps += s0[r] + s1[r]; }
            lsum += ps;
            } else {
#pragma unroll
            for (int r = 0; r < 16; ++r) { s0[r] = __builtin_amdgcn_exp2f(s0[r]); s1[r] = __builtin_amdgcn_exp2f(s1[r]); }
            }
            bf16x8 pk[4];
            { u32x4 w;
              w.x = pk2(s0[0], s0[1]); w.y = pk2(s0[2], s0[3]); w.z = pk2(s0[4], s0[5]); w.w = pk2(s0[6], s0[7]); pk[0] = __builtin_bit_cast(bf16x8, w);
              w.x = pk2(s0[8], s0[9]); w.y = pk2(s0[10], s0[11]); w.z = pk2(s0[12], s0[13]); w.w = pk2(s0[14], s0[15]); pk[1] = __builtin_bit_cast(bf16x8, w);
              w.x = pk2(s1[0], s1[1]); w.y = pk2(s1[2], s1[3]); w.z = pk2(s1[4], s1[5]); w.w = pk2(s1[6], s1[7]); pk[2] = __builtin_bit_cast(bf16x8, w);
              w.x = pk2(s1[8], s1[9]); w.y = pk2(s1[10], s1[11]); w.z = pk2(s1[12], s1[13]); w.w = pk2(s1[14], s1[15]); pk[3] = __builtin_bit_cast(bf16x8, w); }
#pragma unroll
            for (int kc = 0; kc < 4; ++kc) {
                u32x2 a, bq, c2, d2;
                if (!TRACK && kc < 2) { a = vq[4 * kc]; bq = vq[4 * kc + 1]; c2 = vq[4 * kc + 2]; d2 = vq[4 * kc + 3]; }
                else { const LAS unsigned char* vp0 = Vbuf + (r32 * 68 + kc * 16 + 4 * hi) * 2; const LAS unsigned char* vp1 = vp0 + 32 * 68 * 2;
                    a = *(const LAS u32x2*)vp0; bq = *(const LAS u32x2*)(vp0 + 16); c2 = *(const LAS u32x2*)vp1; d2 = *(const LAS u32x2*)(vp1 + 16); }
                const bf16x8 v0 = __builtin_bit_cast(bf16x8, ((u32x4){a.x, a.y, bq.x, bq.y})), v1 = __builtin_bit_cast(bf16x8, ((u32x4){c2.x, c2.y, d2.x, d2.y}));
                o0 = __builtin_amdgcn_mfma_f32_32x32x16_bf16(v0, pk[kc], o0, 0, 0, 0);
                o1 = __builtin_amdgcn_mfma_f32_32x32x16_bf16(v1, pk[kc], o1, 0, 0, 0);
                if (!TRACK) lacc = __builtin_amdgcn_mfma_f32_32x32x16_bf16(ones, pk[kc], lacc, 0, 0, 0);
            }
        }
        if (j + 1 < nt) { LAS unsigned char* nb = lds + (cur ^ 1) * 18432; *(LAS u32x4*)(nb + (srow * 72 + sc * 8) * 2) = kreg; LAS u32x2* vw_ = (LAS u32x2*)(nb + 9216 + (srow * 68 + sc * 8) * 2); vw_[0] = (u32x2){vreg.x, vreg.y}; vw_[1] = (u32x2){vreg.z, vreg.w}; }
        __syncthreads();
    }
    const float ltot = TRACK ? lsum + __shfl_xor(lsum, 32) : lacc[0]; const float inv = 1.0f / ltot;
    {
        LAS unsigned char* scr = lds + 40960 + wave * 8704;
#pragma unroll
        for (int dh = 0; dh < 2; ++dh)
#pragma unroll
            for (int rg = 0; rg < 4; ++rg) { const int d = dh * 32 + 8 * rg + 4 * hi;
                f32x4 ov; ov.x = (dh == 0 ? o0[4 * rg] : o1[4 * rg]) * inv; ov.y = (dh == 0 ? o0[4 * rg + 1] : o1[4 * rg + 1]) * inv; ov.z = (dh == 0 ? o0[4 * rg + 2] : o1[4 * rg + 2]) * inv; ov.w = (dh == 0 ? o0[4 * rg + 3] : o1[4 * rg + 3]) * inv;
                *(LAS f32x4*)(scr + r32 * 272 + d * 4) = ov; }
        const int pc = lane & 7;
#pragma unroll
        for (int i = 0; i < 4; ++i) { const int rw = i * 8 + (lane >> 3), row = wave * 32 + rw;
            const f32x4 oa = *(const LAS f32x4*)(scr + rw * 272 + pc * 32), ob = *(const LAS f32x4*)(scr + rw * 272 + pc * 32 + 16);
            float gv[8]; unpack8(*(const u32x4*)(gate + (size_t)row * INW + 8 * pc), gv);
            u32x4 w; w.x = pk2(oa.x * silu_f(gv[0]), oa.y * silu_f(gv[1])); w.y = pk2(oa.z * silu_f(gv[2]), oa.w * silu_f(gv[3]));
            w.z = pk2(ob.x * silu_f(gv[4]), ob.y * silu_f(gv[5])); w.w = pk2(ob.z * silu_f(gv[6]), ob.w * silu_f(gv[7]));
            *(u32x4*)(outp + (size_t)row * DM + 8 * pc) = w; }
    }
}

template <int MT, int NP>
__device__ __forceinline__ void hyena_unit(const Params& p, LAS unsigned char* lds, int l, int c, bool isctx, int tid, int lane, int wave, int o_hi = 2) {
    constexpr int L = 256 * MT * NP, CS = 2 * L + 16, NCH = L / 256, IMGB = 8 * CS * 2, BROW = 264, BBUF = 32 * BROW * 2;
    const int posoff = isctx ? 0 : 256, set = isctx ? 2 : l;
    const int r32 = lane & 31, hi = lane >> 5;
    const bf16* HU = (const bf16*)(p.ws + WS_HU); bf16* Z1 = (bf16*)(p.ws + WS_Z1) + (size_t)c * 32 * KEYS;
    bf16* MIX = (bf16*)(p.ws + WS_HN);
    const float* Rset = (const float*)(p.ws + WS_RRAW) + (set == 0 ? 0 : set == 1 ? (size_t)512 * 4096 : (size_t)2 * 512 * 4096);
    const float* fnorm = (const float*)(p.ws + WS_FNORM) + set * 512;
    LAS unsigned char* bb = lds + IMGB;
    const int sb0 = tid >> 5, sp0 = tid & 31;
#pragma unroll 1
    for (int o = 0; o < o_hi; ++o) {
        __syncthreads();
        for (int rep_ = 0; rep_ < 1 + (REP_HY & 1); ++rep_)
        { const float inv = 1.0f / fnorm[o * 256 + c]; const float* Rs = Rset + (size_t)(o * 256 + c) * (2 * L);
          LAS unsigned* img = (LAS unsigned*)lds;
#pragma unroll 4
          for (int idx = tid; idx < 8 * (CS / 2); idx += 512) { const int r = idx / (CS / 2), mp = idx - r * (CS / 2), n = 2 * mp + r;
              const float v0 = n <= 2 * L - 2 ? Rs[n] * inv : 0.f, v1 = n + 1 <= 2 * L - 2 ? Rs[n + 1] * inv : 0.f; img[idx] = pk2(v0, v1); } }
        if (o == 1) { __builtin_amdgcn_fence(__ATOMIC_RELEASE, "workgroup"); __syncthreads(); __builtin_amdgcn_fence(__ATOMIC_ACQUIRE, "agent"); }
        const bf16* Uin = (o == 0 ? HU + (size_t)c * 32 * KEYS : (const bf16*)Z1) + posoff;
        const bf16* Xg = HU + (size_t)((o + 1) * 256 + c) * 32 * KEYS + posoff;
        const float db = p.hy_bias[(l * 2 + o) * 256 + c];
        const int b = r32;
        const int rr = 7 - (r32 & 7);
        { const u32x4 g0 = *(const u32x4*)(Uin + (size_t)sb0 * KEYS + 8 * sp0), g1 = *(const u32x4*)(Uin + (size_t)(sb0 + 16) * KEYS + 8 * sp0);
          *(LAS u32x4*)(bb + (sb0 * BROW + 8 * sp0) * 2) = g0; *(LAS u32x4*)(bb + ((sb0 + 16) * BROW + 8 * sp0) * 2) = g1; }
        __syncthreads();
        int it = 0; constexpr int NRUN = 1 + ((REP_HY >> 1) & 1);
#pragma unroll 1
        for (int pp = 0; pp < NP; ++pp) {
            const int tw = 32 * (pp * 8 + wave) * MT;
            f32x16 acc[MT];
            const LAS unsigned char* ab = lds + (rr * CS + (L - 8 - 8 * (r32 >> 3) + 8 * hi) - tw) * 2;
            bf16x8 aw[2][MT];
#pragma unroll 1
            for (int run = 0; run < NRUN; ++run) {
#pragma unroll
            for (int i = 0; i < MT; ++i)
#pragma unroll
                for (int r = 0; r < 16; ++r) acc[i][r] = 0.f;
#pragma unroll
            for (int kv = 1; kv <= 2 * MT - 2; ++kv) aw[kv & 1][((-kv) >> 1) & (MT - 1)] = *(const LAS bf16x8*)(ab + (-16 * kv) * 2);
#pragma unroll 1
            for (int ch = 0; ch < NCH; ++ch) {
                const int cur = it & 1; const bool more = it + 1 < NP * NCH * NRUN; const int nch = (ch + 1 == NCH) ? 0 : ch + 1; ++it;
                u32x4 g0, g1;
                if (more) { g0 = *(const u32x4*)(Uin + (size_t)sb0 * KEYS + nch * 256 + 8 * sp0); g1 = *(const u32x4*)(Uin + (size_t)(sb0 + 16) * KEYS + nch * 256 + 8 * sp0); }
                const LAS unsigned char* bc = bb + cur * BBUF + (r32 * BROW + 8 * hi) * 2;
                const LAS unsigned char* ac = ab + (ch * 256) * 2;
#pragma unroll
                for (int kk = 0; kk < 16; ++kk) {
                    const int par = kk & 1, s = (kk >> 1) & (MT - 1);
                    aw[par][s] = *(const LAS bf16x8*)(ac + (16 * kk) * 2);
                    const bf16x8 bfr = *(const LAS bf16x8*)(bc + (16 * kk) * 2);
#pragma unroll
                    for (int i = 0; i < MT; ++i) acc[i] = __builtin_amdgcn_mfma_f32_32x32x16_bf16(bfr, aw[par][(s - i) & (MT - 1)], acc[i], 0, 0, 0);
                }
                if (more) { LAS unsigned char* nb = bb + (cur ^ 1) * BBUF; *(LAS u32x4*)(nb + (sb0 * BROW + 8 * sp0) * 2) = g0; *(LAS u32x4*)(nb + ((sb0 + 16) * BROW + 8 * sp0) * 2) = g1; }
                __syncthreads();
            }
            }
            { bf16* Zo = (o == 0 ? Z1 : (bf16*)(p.ws + WS_HU) + (size_t)c * 32 * KEYS) + posoff;
#pragma unroll
              for (int i = 0; i < MT; ++i) { const int t = tw + 32 * i + r32;
                const unsigned off0 = (unsigned)(4 * hi) * KEYS + (unsigned)t;
#pragma unroll
                for (int hf = 0; hf < 2; ++hf) {
                    unsigned uu[8], xx[8];
#pragma unroll
                    for (int q = 0; q < 8; ++q) { const int r = 8 * hf + q; const unsigned off = off0 + (unsigned)((r & 3) + 8 * (r >> 2)) * KEYS; uu[q] = Uin[off]; xx[q] = Xg[off]; }
#pragma unroll
                    for (int q = 0; q < 8; ++q) { const int r = 8 * hf + q; const unsigned off = off0 + (unsigned)((r & 3) + 8 * (r >> 2)) * KEYS;
                        const float z = bf2f(xx[q]) * (acc[i][r] + db * bf2f(uu[q])); Zo[off] = (bf16)(pk2(z, 0.f) & 0xffffu); }
                    asm volatile("" ::: "memory");
                }
              } }
        }
    }
}

template <int PH_EN_T>
__device__ __forceinline__ void p3_mixers(const Params& p, LAS unsigned char* lds, int l, const int tid_in, const int lane_in, int wave, int G) {
    const int tid = tid_in, lane = lane_in;
    const int total = 256 + 1536 + 1536 + (l == 0 ? 256 + 192 + 192 : 0);
    const bf16* PROJ = (const bf16*)(p.ws + WS_PROJ); bf16* MIX = (bf16*)(p.ws + WS_HN);
    bool ntA, ntC;
    { float a = fabsf(p.qn_a[l * 64 + lane]), bq = fabsf(p.kn_a[l * 64 + lane]), cc = fabsf(p.qn_c[l * 64 + lane]), d = fabsf(p.kn_c[l * 64 + lane]);
#pragma unroll
      for (int o = 1; o < 64; o <<= 1) { a = fmaxf(a, __shfl_xor(a, o)); bq = fmaxf(bq, __shfl_xor(bq, o)); cc = fmaxf(cc, __shfl_xor(cc, o)); d = fmaxf(d, __shfl_xor(d, o)); }
      float sk = 0.f;
      for (int h = 0; h < 6; ++h) sk = fmaxf(sk, fabsf(p.sink_c[l * 6 + h]) * LOG2E);
      ntA = 11.6f * a * bq < 60.f; ntC = (11.6f * cc * d < 60.f) && (sk < 60.f); }
    const int tid_ph = tid, lane_ph = lane;
    const int vb = (G % 8 == 0) ? ((int)blockIdx.x % 8) * (G / 8) + (int)blockIdx.x / 8 : (int)blockIdx.x;
    for (int u = vb; u < total; u += G) {
        int tid = tid_ph; asm volatile("" : "+v"(tid)); tid &= 511; const int lane = tid & 63; (void)lane_ph;
        if (u < 256) { if (PH_EN_T & 16) { for (int rep = 0; rep < 1 + (REP_UNIT & 1); ++rep) hyena_unit<4, 2>(p, lds, l, u, false, tid, lane, wave, rep ? 1 : 2); } }
        else if (u < 3328) { if (PH_EN_T & 32) {
            const bool isC = u >= 1792; const int v = u - (isC ? 1792 : 256), b = v / 48, rem = v % 48, h = rem >> 3, qb = rem & 7, kvh = h / 3;
            const float* ropet = (const float*)(p.ws + WS_ROPE); const float* qnw = (isC ? p.qn_c : p.qn_a) + l * 64;
            const bf16* Kb = (const bf16*)(p.ws + (isC ? WS_KC : WS_KA)) + (size_t)(b * 2 + kvh) * KEYS * 64;
            const bf16* Vt = (const bf16*)(p.ws + (isC ? WS_VCT : WS_VAT)) + (size_t)(b * 2 + kvh) * 64 * KEYS;
            const size_t row0 = (size_t)b * 2048 + qb * 256;
            if (!isC) { for (int rep = 0; rep < 1 + ((REP_UNIT >> 1) & 1); ++rep) { if (ntA) attn_unit<false>(lds, PROJ + row0 * INW + h * 64, qnw, ropet, qb * 256, Kb, Vt, 36, 0, 0, 0, false, 0.f, 0.f, PROJ + row0 * INW + 640 + h * 64, MIX + row0 * DM + h * 64, tid, lane, wave);
                else attn_unit<true>(lds, PROJ + row0 * INW + h * 64, qnw, ropet, qb * 256, Kb, Vt, 36, 0, 0, 0, false, 0.f, 0.f, PROJ + row0 * INW + 640 + h * 64, MIX + row0 * DM + h * 64, tid, lane, wave); } }
            else { const int lo = 4 + (4 * qb - 2 > 0 ? 4 * qb - 2 : 0), hi_ = (4 + 4 * qb + 6) < 36 ? (4 + 4 * qb + 6) : 36;
                for (int rep = 0; rep < 1 + ((REP_UNIT >> 2) & 1); ++rep) { if (ntC) attn_unit<false>(lds, PROJ + row0 * INW + 2048 + h * 64, qnw, ropet, qb * 256, Kb, Vt, 4, lo, hi_, qb * 256, true, p.sink_c[l * 6 + h] * LOG2E, 1.f, PROJ + row0 * INW + 2048 + 640 + h * 64, MIX + row0 * DM + 640 + h * 64, tid, lane, wave);
                    else attn_unit<true>(lds, PROJ + row0 * INW + 2048 + h * 64, qnw, ropet, qb * 256, Kb, Vt, 4, lo, hi_, qb * 256, true, p.sink_c[l * 6 + h] * LOG2E, 1.f, PROJ + row0 * INW + 2048 + 640 + h * 64, MIX + row0 * DM + 640 + h * 64, tid, lane, wave); } }
        } } else if (u < 3584) { if (PH_EN_T & 64) hyena_unit<1, 1>(p, lds, l, u - 3328, true, tid, lane, wave); }
        else if (PH_EN_T & 32) {
            const bool isC = u >= 3776; const int v = u - (isC ? 3776 : 3584), b = v / 6, h = v % 6, kvh = h / 3;
            const float* ropet = (const float*)(p.ws + WS_ROPE); const float* qnw = (isC ? p.qn_c : p.qn_a) + l * 64;
            const bf16* Kb = (const bf16*)(p.ws + (isC ? WS_KC : WS_KA)) + (size_t)(b * 2 + kvh) * KEYS * 64;
            const bf16* Vt = (const bf16*)(p.ws + (isC ? WS_VCT : WS_VAT)) + (size_t)(b * 2 + kvh) * 64 * KEYS;
            const size_t row0 = (size_t)MLAT + b * 256;
            if (!isC) { if (ntA) attn_unit<false>(lds, PROJ + row0 * INW + h * 64, qnw, ropet, -1, Kb, Vt, 4, 0, 0, 0, false, 0.f, 0.f, PROJ + row0 * INW + 640 + h * 64, MIX + row0 * DM + h * 64, tid, lane, wave);
                else attn_unit<true>(lds, PROJ + row0 * INW + h * 64, qnw, ropet, -1, Kb, Vt, 4, 0, 0, 0, false, 0.f, 0.f, PROJ + row0 * INW + 640 + h * 64, MIX + row0 * DM + h * 64, tid, lane, wave); }
            else { if (ntC) attn_unit<false>(lds, PROJ + row0 * INW + 2048 + h * 64, qnw, ropet, -1, Kb, Vt, 4, 0, 0, 0, false, p.sink_c[l * 6 + h] * LOG2E, 1.f, PROJ + row0 * INW + 2048 + 640 + h * 64, MIX + row0 * DM + 640 + h * 64, tid, lane, wave);
                else attn_unit<true>(lds, PROJ + row0 * INW + 2048 + h * 64, qnw, ropet, -1, Kb, Vt, 4, 0, 0, 0, false, p.sink_c[l * 6 + h] * LOG2E, 1.f, PROJ + row0 * INW + 2048 + 640 + h * 64, MIX + row0 * DM + 640 + h * 64, tid, lane, wave); }
        }
    }
}

__device__ __forceinline__ void p4_transpose_tile(const Params& p, LAS unsigned char* lds, int pm, int tid) {
    const bf16* HOUT = (const bf16*)(p.ws + WS_HU); bf16* MIX = (bf16*)(p.ws + WS_HN);
    const int b = pm < 256 ? (pm >> 3) : pm - 256, pos0 = pm < 256 ? 256 + (pm & 7) * 256 : 0;
    LAS bf16* tile = (LAS bf16*)lds;
    u32x4 pv[4];
#pragma unroll
    for (int q = 0; q < 4; ++q) { const int idx = tid + 512 * q, cc = idx >> 3, pc = idx & 7; pv[q] = *(const u32x4*)(HOUT + ((size_t)cc * 32 + b) * KEYS + pos0 + 8 * pc); }
    for (int sub = 0; sub < 4; ++sub) {
        __syncthreads();
#pragma unroll
        for (int q = 0; q < 4; ++q) { const int idx = tid + 512 * q, cc = idx >> 3, pc = idx & 7;
            LAS unsigned* d = (LAS unsigned*)(tile + cc * 66 + 8 * pc); d[0] = pv[q].x; d[1] = pv[q].y; d[2] = pv[q].z; d[3] = pv[q].w; }
        __syncthreads();
        if (sub + 1 < 4) {
#pragma unroll
            for (int q = 0; q < 4; ++q) { const int idx = tid + 512 * q, cc = idx >> 3, pc = idx & 7; pv[q] = *(const u32x4*)(HOUT + ((size_t)cc * 32 + b) * KEYS + pos0 + (sub + 1) * 64 + 8 * pc); } }
        const int lane_ = tid & 63, wv_ = tid >> 6;
#pragma unroll
        for (int q = 0; q < 4; ++q) { const int slot = wv_ + 8 * q, t = (slot & 7) * 8 + (lane_ >> 3), piece = (slot >> 3) * 8 + (lane_ & 7), c0 = 8 * piece;
            unsigned w[4];
#pragma unroll
            for (int e = 0; e < 4; ++e) w[e] = (unsigned)tile[(c0 + 2 * e) * 66 + t] | ((unsigned)tile[(c0 + 2 * e + 1) * 66 + t] << 16);
            *(u32x4*)(MIX + (size_t)(256 * pm + sub * 64 + t) * DM + 384 + c0) = (u32x4){w[0], w[1], w[2], w[3]}; }
    }
}
struct RowOrder {
    int c, nM;
    __device__ __forceinline__ bool next(int i, pg8::Unit& u) const {
        if (i < 4) { u.pm = c; u.pn = i; return c < nM; }
        if (i == 4 && nM > 256 && c < 128) { u.pm = 256 + (c >> 2); u.pn = c & 3; return true; }
        return false;
    }
    __device__ __forceinline__ void a_ready(const pg8::Unit&) const {}
    __device__ __forceinline__ void done(const pg8::Unit&) const {}
};

struct InOrder {
    pg8::StaticOrder so; int G, c, ncols;
    __device__ __forceinline__ bool next(int i, pg8::Unit& u) const {
        if (so.next(i, u)) return true;
        const int e = (i - 12) * G + c;
        if (i < 12 || e >= 32 * ncols) return false;
        const int j = e % ncols; u.pm = 256 + e / ncols; u.pn = ncols == 12 ? j : (j < 2 ? 1 + j : 7 + j);
        return true;
    }
    __device__ __forceinline__ void a_ready(const pg8::Unit&) const {}
    __device__ __forceinline__ void done(const pg8::Unit&) const {}
};

#define XB_TMO      128
#define XB_XCNT(j)  (256  + 64 * (j))
#define XB_XSUB(j)  (1280 + 64 * (j))
#define XB_XGEN(j)  (2304 + 64 * (j))
#define XB_TOP      3328
#define XB_TOPGEN   3392
#define XCD_BAR_WORDS 3456
#define XB_SPIN_CAP (1u << 18)

__device__ __forceinline__ unsigned xb_ld(unsigned* p)              { return __hip_atomic_load(p, __ATOMIC_RELAXED, __HIP_MEMORY_SCOPE_AGENT); }
__device__ __forceinline__ unsigned xb_add(unsigned* p, unsigned v) { return __hip_atomic_fetch_add(p, v, __ATOMIC_RELAXED, __HIP_MEMORY_SCOPE_AGENT); }
__device__ __forceinline__ unsigned xb_xcc_id() { return (unsigned)__builtin_amdgcn_s_getreg((3 << 11) | 20) & 0xFu; }
#define XB_SPIN(cond, bar) do { unsigned _sp = 0; while (cond) { __builtin_amdgcn_s_sleep(1); \
    if ((++_sp & 255u) == 0u) { if (xb_ld(&(bar)[XB_TMO])) break; if (_sp > XB_SPIN_CAP) { atomicAdd(&(bar)[XB_TMO], 1u); break; } } } } while (0)

struct XcdBarrier {
    unsigned* bar; unsigned x;
    volatile LAS unsigned* st;
};

__device__ __forceinline__ XcdBarrier xcd_barrier_post(unsigned* bar, volatile LAS unsigned* st) {
    XcdBarrier b; b.bar = bar; b.x = xb_xcc_id(); b.st = st;
    if (threadIdx.x == 0) (void)xb_add(&bar[XB_XCNT(b.x)], 1u);
    return b;
}
__device__ __forceinline__ void xcd_barrier_complete(unsigned* bar, unsigned x, unsigned& nloc, unsigned& nx) {
    const unsigned G = gridDim.x * gridDim.y * gridDim.z;
    unsigned sum, cnt, mine, sp = 0u;
    for (;;) {
        sum = 0u; cnt = 0u; mine = 0u;
#pragma unroll
        for (unsigned j = 0; j < 16; ++j) { const unsigned c = xb_ld(&bar[XB_XCNT(j)]); sum += c; cnt += (c > 0u) ? 1u : 0u; mine = (j == x) ? c : mine; }
        if (sum == G) break;
        __builtin_amdgcn_s_sleep(1);
        if ((++sp & 255u) == 0u) { if (xb_ld(&bar[XB_TMO])) break; if (sp > XB_SPIN_CAP) { atomicAdd(&bar[XB_TMO], 1u); break; } }
    }
    nloc = mine > 0u ? mine : 1u; nx = cnt > 0u ? cnt : 1u;
}

__device__ __forceinline__ void xcd_barrier(const XcdBarrier& b) {
    asm volatile("s_waitcnt vmcnt(0)" ::: "memory");
    __syncthreads();
    if (threadIdx.x == 0) {
        unsigned* bar = b.bar;
        __builtin_amdgcn_s_waitcnt(0);
        unsigned nloc = b.st[0], nx = b.st[1];
        if (nloc == 0u) { xcd_barrier_complete(bar, b.x, nloc, nx); b.st[0] = nloc; b.st[1] = nx; }
        const unsigned old = xb_add(&bar[XB_XSUB(b.x)], 1u);
        const unsigned gen = old / nloc;
        if (old + 1u == (gen + 1u) * nloc) {
            __builtin_amdgcn_fence(__ATOMIC_RELEASE, "agent");
            asm volatile("s_waitcnt vmcnt(0)" ::: "memory");
            const unsigned og = xb_add(&bar[XB_TOP], 1u);
            const unsigned tg = og / nx;
            if (og + 1u == (tg + 1u) * nx) xb_add(&bar[XB_TOPGEN], 1u);
            else XB_SPIN(xb_ld(&bar[XB_TOPGEN]) == tg, bar);
            __builtin_amdgcn_fence(__ATOMIC_ACQUIRE, "agent");
            xb_add(&bar[XB_XGEN(b.x)], 1u);
            asm volatile("s_waitcnt vmcnt(0)" ::: "memory");
        } else {
            XB_SPIN(xb_ld(&bar[XB_XGEN(b.x)]) == gen, bar);
            __builtin_amdgcn_fence(__ATOMIC_ACQUIRE, "agent");
            asm volatile("s_waitcnt vmcnt(0)" ::: "memory");
        }
    }
    __syncthreads();
}

#ifndef PH_EN
#define PH_EN 0xff
#endif
constexpr int N_PHASES = 11;
template <int PH_EN_T>
__global__ void __launch_bounds__(512, 2) mega_fwd(Params p_unused) {
    extern __shared__ __attribute__((aligned(16))) unsigned char lds_raw[];
    LAS unsigned char* lds = (LAS unsigned char*)lds_raw;
#if LAUNDER_ARG
    const Params* kp0 = (const Params*)__builtin_amdgcn_kernarg_segment_ptr();
    int ph_lo, ph_hi; { const Params* q = kp0; asm volatile("" : "+s"(q)); ph_lo = q->ph_lo; ph_hi = q->ph_hi; }
#else
    const int ph_lo = p_unused.ph_lo, ph_hi = p_unused.ph_hi;
#endif
    volatile LAS unsigned* xst = (volatile LAS unsigned*)(lds + 131072 + 2048);
    if (threadIdx.x < 2) xst[threadIdx.x] = 0u;
    __syncthreads();
    unsigned* barw;
#if MK_SINGLE
    { const Params& p0 = p_unused; barw = (unsigned*)(p0.ws + WS_XBAR); }
    XcdBarrier xbar = xcd_barrier_post(barw, xst);
#endif
    int repdone = 0; int nsync = 0;
    for (int ph = ph_lo; ph < ph_hi; ++ph) {
        if (ph == 6) continue;
        if (ph > ph_lo || repdone) {
#if MK_SINGLE
            if (ph_hi > 1000) cg::this_grid().sync();
            xcd_barrier(xbar);
            ++nsync;
#else
            cg::this_grid().sync();
#endif
        }
#if LAUNDER_ARG
        const Params* kq = kp0; asm volatile("" : "+s"(kq) :: "memory");
        const Params& p = *kq;
#else
        const Params& p = p_unused;
#endif
#if LAUNDER_TID
        int tid = threadIdx.x; asm volatile("" : "+v"(tid)); tid &= 511;
#else
        const int tid = threadIdx.x;
#endif
        const int lane = tid & 63, wave = __builtin_amdgcn_readfirstlane(tid >> 6), G = gridDim.x;
        if (ph == 0) { if (PH_EN_T & 1) { p0_all(p, lds, tid, lane, wave, G, 1.0f); if (REP_PH & 1) { __syncthreads(); p0_all(p, lds, tid, lane, wave, G, 0.0f); } } continue; }
        const int l = (ph - 1) / 5, sub = (ph - 1) % 5;
        if (sub == 0) { if (PH_EN_T & 2) { const int per = MTOT / G; p1_norm(p, l, lane, (int)blockIdx.x * per, (int)blockIdx.x * per + per, wave, 8); } }
        else if (sub == 1) { if (PH_EN_T & 4) {
            pg8::Gemm g{(const bf16*)(p.ws + WS_HN), (const bf16*)(p.ws + WS_WINT) + (size_t)l * 3072 * 1024, MTOT, INW, DM};
            if (l == 1 && blockIdx.x < 128) { const int r0 = MLAT + ((int)blockIdx.x >> 2) * 256; p1_norm(p, 1, lane, r0, r0 + 256, wave, 8);
                __builtin_amdgcn_fence(__ATOMIC_RELEASE, "workgroup"); __syncthreads(); __builtin_amdgcn_fence(__ATOMIC_ACQUIRE, "agent"); }
            InOrder S; S.so.init(MLAT, INW, G, (int)blockIdx.x); S.G = G; S.c = (int)blockIdx.x; S.ncols = l == 0 ? 12 : 4;
            pg8::EpiBf16<0> E{(bf16*)(p.ws + WS_PROJ), INW, nullptr, 0, 0, 1.f};
            pg8::gemm_phase<pg8::EpiBf16<0>, InOrder, true, true>(lds, g, S, E, tid);
        } }
        else if (sub == 2) { if (PH_EN_T & 8) p2b_prep(p, lds, l, tid, lane, wave, G); }
        else if (sub == 3) { p3_mixers<PH_EN_T>(p, lds, l, tid, lane, wave, G); }
        else if (PH_EN_T & 128) {
            const int M = l == 0 ? MTOT : MLAT;
            pg8::Gemm g{(const bf16*)(p.ws + WS_HN), (const bf16*)(p.ws + WS_WOUTT) + (size_t)l * 1024 * 1024, M, DM, DM};
            RowOrder S{(int)blockIdx.x, M / 256};
            p4_transpose_tile(p, lds, (int)blockIdx.x, tid);
            if (l == 0 && blockIdx.x < 128) p4_transpose_tile(p, lds, 256 + ((int)blockIdx.x >> 2), tid);
            __builtin_amdgcn_fence(__ATOMIC_RELEASE, "workgroup"); __syncthreads(); __builtin_amdgcn_fence(__ATOMIC_ACQUIRE, "agent");
            EpiResGate E{l == 0 ? p.x : p.out, p.out, p.ctx, (float*)(p.ws + WS_CTX1), (const float*)(p.ws + WS_MOD) + (size_t)l * 33 * 3072};
            pg8::gemm_phase<EpiResGate, RowOrder, true, true>(lds, g, S, E, tid);
            if (l == 0) { __builtin_amdgcn_fence(__ATOMIC_RELEASE, "workgroup"); __syncthreads(); __builtin_amdgcn_fence(__ATOMIC_ACQUIRE, "agent");
                p1_norm(p, 1, lane, 256 * (int)blockIdx.x, 256 * (int)blockIdx.x + 256, wave, 8); }
        }
        if (REP_PH) { if (((REP_PH >> ph) & 1) && !repdone) { repdone = 1; --ph; } else repdone = 0; }
    }
}

extern "C" void kernel_launch(void* const* d_in, const int* in_sizes, int n_in, void* d_out, int out_size, void* d_ws, size_t ws_size, hipStream_t stream) {
    static int grid = 0;
    if (grid == 0) {
        if (n_in != 23 || ws_size < WS_END) { fprintf(stderr, "kernel_launch: unexpected n_in %d / ws_size %zu\n", n_in, ws_size); grid = -1; return; }
        int dev = 0, cus = 0, per_cu = 0;
        hipGetDevice(&dev); hipDeviceGetAttribute(&cus, hipDeviceAttributeMultiprocessorCount, dev);
#if MK_SINGLE
        if (hipFuncSetAttribute((const void*)mega_fwd<PH_EN>, hipFuncAttributeMaxDynamicSharedMemorySize, LDS_BYTES) != hipSuccess) { fprintf(stderr, "hipFuncSetAttribute failed\n"); grid = -1; return; }
        (void)hipOccupancyMaxActiveBlocksPerMultiprocessor(&per_cu, (const void*)mega_fwd<PH_EN>, 512, LDS_BYTES);
        if (per_cu < 1) { fprintf(stderr, "occupancy query: %d blocks per CU\n", per_cu); per_cu = 1; }
#endif
        (void)hipGetLastError();
        grid = cus * 1;
    }
    if (grid < 0) return;
    hipMemsetAsync((char*)d_ws, 0, WS_ZERO_BYTES, stream);
    Params p{};
    const float** pp = (const float**)&p;
    for (int i = 0; i < 23; ++i) pp[i] = (const float*)d_in[i];
    p.out = (float*)d_out; p.ws = (unsigned char*)d_ws;
#if MK_SINGLE
    p.ph_lo = 0; p.ph_hi = N_PHASES;
    void* args[] = {&p};
    hipError_t e = hipLaunchCooperativeKernel((const void*)mega_fwd<PH_EN>, dim3(grid), dim3(512), args, LDS_BYTES, stream);
    if (e != hipSuccess) fprintf(stderr, "cooperative launch failed: %s (grid %d)\n", hipGetErrorString(e), grid);
#else
    static bool attr_done = false;
    if (!attr_done) { attr_done = true;
        (void)hipFuncSetAttribute((const void*)mega_fwd<1>, hipFuncAttributeMaxDynamicSharedMemorySize, LDS_BYTES); (void)hipFuncSetAttribute((const void*)mega_fwd<2>, hipFuncAttributeMaxDynamicSharedMemorySize, LDS_BYTES);
        (void)hipFuncSetAttribute((const void*)mega_fwd<4>, hipFuncAttributeMaxDynamicSharedMemorySize, LDS_BYTES); (void)hipFuncSetAttribute((const void*)mega_fwd<8>, hipFuncAttributeMaxDynamicSharedMemorySize, LDS_BYTES);
        (void)hipFuncSetAttribute((const void*)mega_fwd<112>, hipFuncAttributeMaxDynamicSharedMemorySize, LDS_BYTES); (void)hipFuncSetAttribute((const void*)mega_fwd<128>, hipFuncAttributeMaxDynamicSharedMemorySize, LDS_BYTES); }
    for (int ph = 0; ph < N_PHASES; ++ph) { p.ph_lo = ph; p.ph_hi = ph + 1; const int sub = ph == 0 ? -1 : (ph - 1) % 5;
        if (sub == -1) hipLaunchKernelGGL(mega_fwd<1>, dim3(grid), dim3(512), LDS_BYTES, stream, p);
        else if (sub == 0) hipLaunchKernelGGL(mega_fwd<2>, dim3(grid), dim3(512), LDS_BYTES, stream, p);
        else if (sub == 1) hipLaunchKernelGGL(mega_fwd<4>, dim3(grid), dim3(512), LDS_BYTES, stream, p);
        else if (sub == 2) hipLaunchKernelGGL(mega_fwd<8>, dim3(grid), dim3(512), LDS_BYTES, stream, p);
        else if (sub == 3) hipLaunchKernelGGL(mega_fwd<112>, dim3(grid), dim3(512), LDS_BYTES, stream, p);
        else hipLaunchKernelGGL(mega_fwd<128>, dim3(grid), dim3(512), LDS_BYTES, stream, p); }
#endif
}
```
